# Optimizing an MI355X kernel written in HIP

```python
import math
import jax, jax.numpy as jnp
from jax import lax
import numpy as np

D_MODEL = 1024
BATCH = 8
SEQ = 4096
DEPTH = 2

GRID_W = 64
D_MIX = D_MODEL
ATTN_WIDTH = D_MIX // 2
SSD_WIDTH = D_MIX - ATTN_WIDTH
HEAD_DIM = 64
N_Q_HEADS = ATTN_WIDTH // HEAD_DIM
N_KV_HEADS = 2
KV_WIDTH = N_KV_HEADS * HEAD_DIM
Q_BLOCK = 128
ROPE_THETA = 10000.0
ROPE_AXIS_DIM = HEAD_DIM // 2
SSD_HEAD_DIM = 64
SSD_HEADS = SSD_WIDTH // SSD_HEAD_DIM
SSD_GROUPS = 2
D_STATE = 128
D_CONV = 5
CONV_PAD = D_CONV // 2
CHUNK = 128
CONV_CH = SSD_WIDTH + 2 * SSD_GROUPS * D_STATE
DT_MIN = 0.001
DT_MAX = 0.1
D_IN_PROJ = ATTN_WIDTH + 2 * KV_WIDTH + SSD_WIDTH + CONV_CH + 2 * SSD_HEADS
D_FF = -(-8 * D_MODEL // (3 * 256)) * 256
EPS = 1e-6

kernel_name = "hybrid_ssd_gqa_axial_rope_encoder"


def rms_norm(x, w):
    xf = x.astype(jnp.float32)
    y = xf * lax.rsqrt(jnp.mean(xf * xf, axis=-1, keepdims=True) + EPS)
    return (y * w.astype(jnp.float32)).astype(x.dtype)


def _rot_half(x, cos, sin):
    x1, x2 = jnp.split(x, 2, axis=-1)
    return jnp.concatenate([x1 * cos - x2 * sin, x2 * cos + x1 * sin], axis=-1)


def axial_rope(x, cos_r, sin_r, cos_c, sin_c):
    xr, xc = jnp.split(x, 2, axis=-1)
    return jnp.concatenate([_rot_half(xr, cos_r, sin_r), _rot_half(xc, cos_c, sin_c)], axis=-1)


def axial_rope_tables(seq_len):
    rows = seq_len // GRID_W
    row_idx, col_idx = jnp.meshgrid(jnp.arange(rows), jnp.arange(GRID_W), indexing="ij")
    row_idx = row_idx.reshape(-1).astype(jnp.float32)
    col_idx = col_idx.reshape(-1).astype(jnp.float32)
    half = ROPE_AXIS_DIM // 2
    inv_freq = ROPE_THETA ** (-(2.0 * jnp.arange(half, dtype=jnp.float32)) / ROPE_AXIS_DIM)
    ang_r = row_idx[:, None] * inv_freq[None, :]
    ang_c = col_idx[:, None] * inv_freq[None, :]
    return (jnp.cos(ang_r)[:, None], jnp.sin(ang_r)[:, None],
            jnp.cos(ang_c)[:, None], jnp.sin(ang_c)[:, None])


def blocked_gqa(q, k, v):
    b, l, hq, d = q.shape
    r = hq // N_KV_HEADS
    nb = l // Q_BLOCK
    qb = (q * (1.0 / math.sqrt(d))).reshape(b, nb, Q_BLOCK, N_KV_HEADS, r, d)
    qb = jnp.moveaxis(qb, 1, 0)

    def one_block(qi):
        s = jnp.einsum("bqgrd,bkgd->bgrqk", qi, k)
        p = jax.nn.softmax(s, axis=-1)
        return jnp.einsum("bgrqk,bkgd->bqgrd", p, v)

    out = lax.map(one_block, qb)
    return jnp.moveaxis(out, 0, 1).reshape(b, l, hq * d)


def depthwise_conv_centred(x, w, bias):
    y = lax.conv_general_dilated(
        x, w[:, None, :].astype(x.dtype), window_strides=(1,), padding=[(CONV_PAD, CONV_PAD)],
        dimension_numbers=("NWC", "WIO", "NWC"), feature_group_count=x.shape[-1])
    return y + bias.astype(x.dtype)


def ssd_chunked(x, dt, a, bm, cm):
    b, l, h, p = x.shape
    g, n = bm.shape[2], bm.shape[3]
    r = h // g
    nc = l // CHUNK
    xc = (x * dt[..., None]).reshape(b, nc, CHUNK, g, r, p)
    ac = (dt * a).reshape(b, nc, CHUNK, g, r)
    bc = bm.reshape(b, nc, CHUNK, g, n)
    cc = cm.reshape(b, nc, CHUNK, g, n)
    a_cs = jnp.cumsum(ac, axis=2)
    diff = a_cs[:, :, :, None] - a_cs[:, :, None, :]
    mask = jnp.tril(jnp.ones((CHUNK, CHUNK), dtype=bool))[:, :, None, None]
    decay = jnp.exp(jnp.where(mask, diff, -jnp.inf))
    scores = jnp.einsum("bclgn,bcsgn->bclsg", cc, bc)
    y_diag = jnp.einsum("bclsgr,bcsgrp->bclgrp", scores[..., None] * decay, xc)
    decay_to_end = jnp.exp(a_cs[:, :, -1:] - a_cs)
    states = jnp.einsum("bclgn,bclgrp->bcgrpn", bc, xc * decay_to_end[..., None])
    chunk_decay = jnp.exp(a_cs[:, :, -1])

    def step(hs, inp):
        dec, st = inp
        return hs * dec[..., None, None] + st, hs

    h0 = jnp.zeros((b, g, r, p, n), dtype=states.dtype)
    _, states_in = lax.scan(step, h0, (jnp.moveaxis(chunk_decay, 1, 0), jnp.moveaxis(states, 1, 0)))
    states_in = jnp.moveaxis(states_in, 0, 1)
    y_off = jnp.einsum("bclgn,bcgrpn->bclgrp", cc, states_in) * jnp.exp(a_cs)[..., None]
    return (y_diag + y_off).reshape(b, l, h, p)


def ssd_mixer(z, xbc_raw, dt_raw, conv_w, conv_b, dt_bias, a_log, d_skip, norm_w):
    b, l, _ = z.shape
    xbc = jax.nn.silu(depthwise_conv_centred(xbc_raw, conv_w, conv_b)).astype(jnp.float32)
    xs, bm, cm = jnp.split(xbc, [SSD_WIDTH, SSD_WIDTH + SSD_GROUPS * D_STATE], axis=-1)
    xs = xs.reshape(b, l, SSD_HEADS, SSD_HEAD_DIM)
    bm = bm.reshape(b, l, SSD_GROUPS, D_STATE)
    cm = cm.reshape(b, l, SSD_GROUPS, D_STATE)
    dt = jax.nn.softplus(dt_raw.astype(jnp.float32).reshape(b, l, 2, SSD_HEADS)
                         + dt_bias.astype(jnp.float32))
    a = -jnp.exp(a_log.astype(jnp.float32))
    y_fwd = ssd_chunked(xs, dt[:, :, 0], a[0], bm, cm)
    flip = lambda t: jnp.flip(t, axis=1)
    y_bwd = flip(ssd_chunked(flip(xs), flip(dt[:, :, 1]), a[1], flip(bm), flip(cm)))
    y = y_fwd + y_bwd + xs * d_skip.astype(jnp.float32)[:, None]
    y = y.reshape(b, l, SSD_WIDTH) * jax.nn.silu(z.astype(jnp.float32))
    yg = y.reshape(b, l, SSD_GROUPS, SSD_WIDTH // SSD_GROUPS)
    yg = yg * lax.rsqrt(jnp.mean(yg * yg, axis=-1, keepdims=True) + EPS)
    return (yg.reshape(b, l, SSD_WIDTH) * norm_w.astype(jnp.float32)).astype(z.dtype)


def setup_inputs(seed: int = 0) -> dict:
    key = jax.random.key(seed)
    ks = jax.random.split(key, 20)
    f32 = jnp.float32
    nrm = lambda k, shape, s: jax.random.normal(k, shape, f32) * s
    dt0 = jnp.exp(jax.random.uniform(ks[7], (DEPTH, 2, SSD_HEADS), f32,
                                     math.log(DT_MIN), math.log(DT_MAX)))
    return {
        "x": jax.random.normal(ks[0], (BATCH, SEQ, D_MODEL), f32),
        "norm_mix_w": 1.0 + nrm(ks[1], (DEPTH, D_MODEL), 0.02),
        "w_in": nrm(ks[2], (DEPTH, D_MODEL, D_IN_PROJ), D_MODEL ** -0.5),
        "q_norm_w": 1.0 + nrm(ks[3], (DEPTH, HEAD_DIM), 0.02),
        "k_norm_w": 1.0 + nrm(ks[4], (DEPTH, HEAD_DIM), 0.02),
        "conv_w": nrm(ks[5], (DEPTH, D_CONV, CONV_CH), D_CONV ** -0.5),
        "conv_b": nrm(ks[6], (DEPTH, CONV_CH), 0.01),
        "dt_bias": dt0 + jnp.log(-jnp.expm1(-dt0)),
        "a_log": jnp.log(jax.random.uniform(ks[8], (DEPTH, 2, SSD_HEADS), f32, 1.0, 16.0)),
        "d_skip": 1.0 + nrm(ks[9], (DEPTH, SSD_HEADS), 0.1),
        "ssd_norm_w": 1.0 + nrm(ks[10], (DEPTH, SSD_WIDTH), 0.02),
        "w_out": nrm(ks[11], (DEPTH, D_MIX, D_MODEL), D_MIX ** -0.5),
        "norm_ffn_w": 1.0 + nrm(ks[12], (DEPTH, D_MODEL), 0.02),
        "w_gate": nrm(ks[13], (DEPTH, D_MODEL, D_FF), D_MODEL ** -0.5),
        "w_up": nrm(ks[14], (DEPTH, D_MODEL, D_FF), D_MODEL ** -0.5),
        "w_down": nrm(ks[15], (DEPTH, D_FF, D_MODEL), D_FF ** -0.5),
        "final_norm_w": 1.0 + nrm(ks[16], (D_MODEL,), 0.02),
    }


def reference(x, norm_mix_w, w_in, q_norm_w, k_norm_w, conv_w, conv_b, dt_bias, a_log, d_skip,
              ssd_norm_w, w_out, norm_ffn_w, w_gate, w_up, w_down, final_norm_w):
    b, l, _ = x.shape
    cos_r, sin_r, cos_c, sin_c = axial_rope_tables(l)
    split_at = np.cumsum([ATTN_WIDTH, KV_WIDTH, KV_WIDTH, SSD_WIDTH, CONV_CH]).tolist()
    for i in range(DEPTH):
        h = rms_norm(x, norm_mix_w[i])
        proj = jnp.einsum("bld,de->ble", h, w_in[i])
        q, k, v, z, xbc_raw, dt_raw = jnp.split(proj, split_at, axis=-1)
        q = rms_norm(q.reshape(b, l, N_Q_HEADS, HEAD_DIM), q_norm_w[i]).astype(jnp.float32)
        k = rms_norm(k.reshape(b, l, N_KV_HEADS, HEAD_DIM), k_norm_w[i]).astype(jnp.float32)
        v = v.reshape(b, l, N_KV_HEADS, HEAD_DIM).astype(jnp.float32)
        q = axial_rope(q, cos_r, sin_r, cos_c, sin_c)
        k = axial_rope(k, cos_r, sin_r, cos_c, sin_c)
        attn_out = blocked_gqa(q, k, v).astype(x.dtype)
        ssd_out = ssd_mixer(z, xbc_raw, dt_raw, conv_w[i], conv_b[i], dt_bias[i], a_log[i],
                            d_skip[i], ssd_norm_w[i])
        mixed = jnp.concatenate([attn_out, ssd_out], axis=-1)
        x = x + jnp.einsum("ble,ed->bld", mixed, w_out[i])
        h = rms_norm(x, norm_ffn_w[i])
        g = jnp.einsum("bld,df->blf", h, w_gate[i])
        u = jnp.einsum("bld,df->blf", h, w_up[i])
        x = x + jnp.einsum("blf,fd->bld", jax.nn.silu(g) * u, w_down[i])
    return rms_norm(x, final_norm_w)
```

```cpp
#include <hip/hip_runtime.h>
#include <cstdint>
#include <cstdio>

constexpr int D_MODEL = 1024, BATCH = 8, SEQ = 4096, DEPTH = 2, M = BATCH * SEQ;
constexpr int NQ = 512, NKV = 128, NSSD = 512, NCONV = 1024, NIN = 2320;
constexpr int DFF = 2816;
constexpr float EPS = 1e-6f;
constexpr float C2 = 0.125f * 1.4426950408889634f;

typedef unsigned short bf16;
constexpr size_t MiB = 1u << 20;
constexpr size_t WS_SSQ = 1 * MiB;
constexpr size_t WS_DT = 3 * MiB;
constexpr size_t WS_RSTD = 5 * MiB;
constexpr size_t WS_ROPE = 5 * MiB + 512 * 1024;
constexpr size_t WS_XN = 56 * MiB;
constexpr size_t WS_MIX = 120 * MiB;
constexpr size_t WS_Q = 184 * MiB;
constexpr size_t WS_K = 216 * MiB;
constexpr size_t WS_V = 224 * MiB;
constexpr size_t WS_Z = 232 * MiB;
constexpr size_t WS_XBCR = 264 * MiB;
constexpr size_t WS_XBC = 328 * MiB;
constexpr size_t WS_ST = 392 * MiB;
constexpr size_t WS_HFF = 184 * MiB;
constexpr size_t WS_TMP = 456 * MiB;

__device__ __forceinline__ float bf2f(bf16 v) { return __uint_as_float((unsigned)v << 16); }
__device__ __forceinline__ bf16 f2bf(float f) { unsigned u = __float_as_uint(f); return (bf16)((u + 0x7fffu + ((u >> 16) & 1u)) >> 16); }
__device__ __forceinline__ float wave_sum(float v) {
#pragma unroll
    for (int o = 1; o < 64; o <<= 1) v += __shfl_xor(v, o);
    return v;
}
__device__ __forceinline__ float silu_f(float v) { return v / (1.f + __expf(-v)); }

__global__ __launch_bounds__(256) void k_rope_tab(float* tab) {
    const int i = blockIdx.x * 256 + threadIdx.x;
    if (i < 1024) { const int pos = i >> 4, j = i & 15; const float inv = powf(10000.f, -(2.0f * (float)j) / 32.f); const float ang = (float)pos * inv; tab[i] = cosf(ang); tab[1024 + i] = sinf(ang); }
}
__global__ __launch_bounds__(256) void k_prep(const float* __restrict__ x, bf16* __restrict__ XN, float* __restrict__ SSQ, float* __restrict__ RSTD) {
    const int row = (blockIdx.x * 256 + threadIdx.x) >> 6, lane = threadIdx.x & 63;
    if (row >= M) return;
    const float4* xr = (const float4*)(x + (size_t)row * D_MODEL);
    float s = 0.f; float4 v[4];
#pragma unroll
    for (int j = 0; j < 4; ++j) { v[j] = xr[lane + 64 * j]; s += v[j].x * v[j].x + v[j].y * v[j].y + v[j].z * v[j].z + v[j].w * v[j].w; }
    s = wave_sum(s);
    ushort4* o = (ushort4*)(XN + (size_t)row * D_MODEL);
#pragma unroll
    for (int j = 0; j < 4; ++j) { ushort4 w; w.x = f2bf(v[j].x); w.y = f2bf(v[j].y); w.z = f2bf(v[j].z); w.w = f2bf(v[j].w); o[lane + 64 * j] = w; }
    if (lane < 16) SSQ[(size_t)row * 16 + lane] = lane == 0 ? s : 0.f;
    if (lane == 0) RSTD[row] = rsqrtf(s * (1.f / D_MODEL) + EPS);
}

struct EpiProj { float* P; const float* rstd; int m_off; __device__ void operator()(int m, int n, float4 a, float4) const { const float r = rstd[m_off + m]; *(float4*)(P + (size_t)m * NIN + n) = make_float4(a.x * r, a.y * r, a.z * r, a.w * r); } };
struct EpiRes { const float* res; float* out; __device__ void operator()(int m, int n, float4 a, float4) const { const float4 r = *(const float4*)(res + (size_t)m * D_MODEL + n); *(float4*)(out + (size_t)m * D_MODEL + n) = make_float4(r.x + a.x, r.y + a.y, r.z + a.z, r.w + a.w); } };
struct EpiSwiglu { bf16* H; const float* rstd; __device__ void operator()(int m, int n, float4 g, float4 u) const { const float r = rstd[m]; ushort4 w;
    w.x = f2bf(silu_f(g.x * r) * (u.x * r)); w.y = f2bf(silu_f(g.y * r) * (u.y * r)); w.z = f2bf(silu_f(g.z * r) * (u.z * r)); w.w = f2bf(silu_f(g.w * r) * (u.w * r)); *(ushort4*)(H + (size_t)m * DFF + n) = w; } };

template <int NB, class Epi>
__global__ __launch_bounds__(256) void k_ngemm(const bf16* __restrict__ A, int lda, const float* __restrict__ B0, const float* __restrict__ B1, int ldb, const float* __restrict__ ks, int N, int K, Epi epi) {
    __shared__ float As[16][68];
    __shared__ float Bs[NB][16][64];
    const int m0 = blockIdx.y * 64, n0 = blockIdx.x * 64, tid = threadIdx.x, tx = tid & 15, ty = tid >> 4;
    float acc[NB][4][4];
#pragma unroll
    for (int b = 0; b < NB; ++b)
#pragma unroll
        for (int i = 0; i < 4; ++i)
#pragma unroll
            for (int j = 0; j < 4; ++j) acc[b][i][j] = 0.f;
    for (int k0 = 0; k0 < K; k0 += 16) {
        { const int r = tid >> 2, kk = (tid & 3) * 4; const ushort4 a = *(const ushort4*)(A + (size_t)(m0 + r) * lda + k0 + kk);
          As[kk][r] = bf2f(a.x); As[kk + 1][r] = bf2f(a.y); As[kk + 2][r] = bf2f(a.z); As[kk + 3][r] = bf2f(a.w); }
        { const int k = tid >> 4, n = n0 + (tid & 15) * 4; const float sc = ks ? ks[k0 + k] : 1.f;
#pragma unroll
          for (int b = 0; b < NB; ++b) { const float* Bb = b ? B1 : B0; float4 v = make_float4(0.f, 0.f, 0.f, 0.f); if (n < N) v = *(const float4*)(Bb + (size_t)(k0 + k) * ldb + n);
              v.x *= sc; v.y *= sc; v.z *= sc; v.w *= sc; *(float4*)&Bs[b][k][(tid & 15) * 4] = v; } }
        __syncthreads();
#pragma unroll
        for (int kk = 0; kk < 16; ++kk) {
            const float4 a = *(const float4*)&As[kk][ty * 4]; const float av[4] = {a.x, a.y, a.z, a.w};
#pragma unroll
            for (int b = 0; b < NB; ++b) { const float4 bb = *(const float4*)&Bs[b][kk][tx * 4]; const float bv[4] = {bb.x, bb.y, bb.z, bb.w};
#pragma unroll
                for (int i = 0; i < 4; ++i)
#pragma unroll
                    for (int j = 0; j < 4; ++j) acc[b][i][j] += av[i] * bv[j]; }
        }
        __syncthreads();
    }
    const int n = n0 + tx * 4;
    if (n < N) {
#pragma unroll
        for (int i = 0; i < 4; ++i) { const int m = m0 + ty * 4 + i;
            epi(m, n, make_float4(acc[0][i][0], acc[0][i][1], acc[0][i][2], acc[0][i][3]), make_float4(acc[NB - 1][i][0], acc[NB - 1][i][1], acc[NB - 1][i][2], acc[NB - 1][i][3])); }
    }
}

__global__ __launch_bounds__(256) void k_post(const float* __restrict__ P, int m_off, const float* __restrict__ qw, const float* __restrict__ kw, const float* __restrict__ tab,
                                              bf16* Q, bf16* Kb, bf16* Vb, bf16* Z, bf16* XR, float* DT) {
    const int lrow = (blockIdx.x * 256 + threadIdx.x) >> 6, lane = threadIdx.x & 63;
    const int m = m_off + lrow, t = m & (SEQ - 1);
    const float* p = P + (size_t)lrow * NIN;
    const int j = lane & 15, pos = (lane < 32) ? (t >> 6) : (t & 63);
    const float cs = tab[pos * 16 + j], sn = tab[1024 + pos * 16 + j];
    const bool first = (lane & 16) == 0;
    for (int h = 0; h < 10; ++h) {
        const float v = p[h * 64 + lane];
        const float ss = wave_sum(v * v);
        const float w = h < 8 ? qw[lane] : kw[lane];
        const float y = v * rsqrtf(ss * (1.f / 64.f) + EPS) * w;
        const float pr = __shfl_xor(y, 16);
        float o = first ? (y * cs - pr * sn) : (y * cs + pr * sn);
        if (h < 8) Q[(size_t)m * NQ + h * 64 + lane] = f2bf(o * C2); else Kb[(size_t)m * NKV + (h - 8) * 64 + lane] = f2bf(o);
    }
    for (int c = lane; c < 128; c += 64) Vb[(size_t)m * NKV + c] = f2bf(p[640 + c]);
    for (int c = lane; c < 512; c += 64) Z[(size_t)m * NSSD + c] = f2bf(p[768 + c]);
    for (int c = lane; c < 1024; c += 64) XR[(size_t)m * NCONV + c] = f2bf(p[1280 + c]);
    if (lane < 16) DT[(size_t)m * 16 + lane] = p[2304 + lane];
}

__global__ __launch_bounds__(256) void k_attn(const bf16* __restrict__ Q, const bf16* __restrict__ Kb, const bf16* __restrict__ Vb, bf16* __restrict__ O) {
    __shared__ float Ks[64][64];
    __shared__ float Vs[64][64];
    const int qb = blockIdx.x & 15, h = (blockIdx.x >> 4) & 7, b = blockIdx.x >> 7, g = h >> 2, tid = threadIdx.x;
    const size_t mrow = (size_t)b * SEQ + qb * 256 + tid;
    float q[64], o[64];
#pragma unroll
    for (int d = 0; d < 64; ++d) { q[d] = bf2f(Q[mrow * NQ + h * 64 + d]); o[d] = 0.f; }
    float mx = -1e30f, l = 0.f;
    for (int kt = 0; kt < SEQ / 64; ++kt) {
        __syncthreads();
        for (int e = tid; e < 64 * 64; e += 256) { const int r = e >> 6, c = e & 63; const size_t km = (size_t)b * SEQ + kt * 64 + r; Ks[r][c] = bf2f(Kb[km * NKV + g * 64 + c]); Vs[r][c] = bf2f(Vb[km * NKV + g * 64 + c]); }
        __syncthreads();
        for (int r = 0; r < 64; ++r) {
            float s = 0.f;
#pragma unroll
            for (int d = 0; d < 64; ++d) s += q[d] * Ks[r][d];
            if (s > mx) { const float f = exp2f(mx - s); l *= f;
#pragma unroll
                for (int d = 0; d < 64; ++d) o[d] *= f;
                mx = s; }
            const float pv = exp2f(s - mx); l += pv;
#pragma unroll
            for (int d = 0; d < 64; ++d) o[d] += pv * Vs[r][d];
        }
    }
    const float il = 1.f / l;
#pragma unroll
    for (int d = 0; d < 64; ++d) O[mrow * D_MODEL + h * 64 + d] = f2bf(o[d] * il);
}

__global__ __launch_bounds__(256) void k_conv(const bf16* __restrict__ XR, const float* __restrict__ cw, const float* __restrict__ cb, bf16* __restrict__ XB) {
    const size_t i = (size_t)blockIdx.x * 256 + threadIdx.x;
    const int c = (int)(i & 1023); const int m = (int)(i >> 10), t = m & (SEQ - 1);
    float a = cb[c];
#pragma unroll
    for (int j = 0; j < 5; ++j) { const int tt = t + j - 2; if (tt >= 0 && tt < SEQ) a += cw[j * NCONV + c] * bf2f(XR[(size_t)(m + j - 2) * NCONV + c]); }
    XB[i] = f2bf(silu_f(a));
}

__global__ __launch_bounds__(256) void k_scan(const bf16* __restrict__ XB, const float* __restrict__ DT, const float* __restrict__ dt_bias, const float* __restrict__ a_log, float* __restrict__ Y0, float* __restrict__ Y1) {
    __shared__ float Bs[32][128];
    __shared__ float Cs[32][128];
    __shared__ float xs[32][64];
    __shared__ float dts[32], decs[32];
    const int dir = blockIdx.x & 1, h = (blockIdx.x >> 1) & 7, b = blockIdx.x >> 4, g = h >> 2, tid = threadIdx.x, p = tid >> 2, nq = tid & 3;
    const float bias = dt_bias[dir * 8 + h], av = -__expf(a_log[dir * 8 + h]);
    float* Y = dir ? Y1 : Y0;
    float st[32];
#pragma unroll
    for (int n = 0; n < 32; ++n) st[n] = 0.f;
    for (int tb = 0; tb < SEQ / 32; ++tb) {
        const int T0 = dir ? (SEQ - 32 - tb * 32) : tb * 32;
        __syncthreads();
        for (int e = tid; e < 32 * 128; e += 256) { const int r = e >> 7, c = e & 127; const size_t mm = (size_t)b * SEQ + T0 + r; Bs[r][c] = bf2f(XB[mm * NCONV + 512 + g * 128 + c]); Cs[r][c] = bf2f(XB[mm * NCONV + 768 + g * 128 + c]); }
        for (int e = tid; e < 32 * 64; e += 256) { const int r = e >> 6, c = e & 63; const size_t mm = (size_t)b * SEQ + T0 + r; xs[r][c] = bf2f(XB[mm * NCONV + h * 64 + c]); }
        if (tid < 32) { const size_t mm = (size_t)b * SEQ + T0 + tid; const float v = DT[mm * 16 + dir * 8 + h] + bias; const float d = fmaxf(v, 0.f) + log1pf(__expf(-fabsf(v))); dts[tid] = d; decs[tid] = __expf(d * av); }
        __syncthreads();
        for (int ii = 0; ii < 32; ++ii) {
            const int i = dir ? 31 - ii : ii;
            const float xv = xs[i][p] * dts[i], dc = decs[i];
            float y = 0.f;
#pragma unroll
            for (int n = 0; n < 32; ++n) { st[n] = st[n] * dc + xv * Bs[i][nq * 32 + n]; y += Cs[i][nq * 32 + n] * st[n]; }
            y += __shfl_xor(y, 1); y += __shfl_xor(y, 2);
            if (nq == 0) Y[((size_t)b * SEQ + T0 + i) * NSSD + h * 64 + p] = y;
        }
    }
}

__global__ __launch_bounds__(256) void k_comb(const float* __restrict__ Y0, const float* __restrict__ Y1, const bf16* __restrict__ XB, const bf16* __restrict__ Z, const float* __restrict__ dsk, const float* __restrict__ nw, bf16* __restrict__ MIX) {
    const int w = (blockIdx.x * 256 + threadIdx.x) >> 6, lane = threadIdx.x & 63;
    const int m = w >> 1, g = w & 1, c0 = g * 256 + lane * 4, h = c0 >> 6;
    const float4 y0 = *(const float4*)(Y0 + (size_t)m * NSSD + c0), y1 = *(const float4*)(Y1 + (size_t)m * NSSD + c0);
    const ushort4 xv = *(const ushort4*)(XB + (size_t)m * NCONV + c0), zv = *(const ushort4*)(Z + (size_t)m * NSSD + c0);
    const float dk = dsk[h];
    float y[4] = {y0.x + y1.x + bf2f(xv.x) * dk, y0.y + y1.y + bf2f(xv.y) * dk, y0.z + y1.z + bf2f(xv.z) * dk, y0.w + y1.w + bf2f(xv.w) * dk};
    const float z[4] = {bf2f(zv.x), bf2f(zv.y), bf2f(zv.z), bf2f(zv.w)};
    float ss = 0.f;
#pragma unroll
    for (int i = 0; i < 4; ++i) { y[i] *= silu_f(z[i]); ss += y[i] * y[i]; }
    ss = wave_sum(ss);
    const float r = rsqrtf(ss * (1.f / 256.f) + EPS);
    const float4 wv = *(const float4*)(nw + c0);
    ushort4 o; o.x = f2bf(y[0] * r * wv.x); o.y = f2bf(y[1] * r * wv.y); o.z = f2bf(y[2] * r * wv.z); o.w = f2bf(y[3] * r * wv.w);
    *(ushort4*)(MIX + (size_t)m * D_MODEL + 512 + c0) = o;
}

__global__ __launch_bounds__(256) void k_final(float* __restrict__ out, const float* __restrict__ fw) {
    const int row = (blockIdx.x * 256 + threadIdx.x) >> 6, lane = threadIdx.x & 63;
    float4* xr = (float4*)(out + (size_t)row * D_MODEL);
    float s = 0.f; float4 v[4];
#pragma unroll
    for (int j = 0; j < 4; ++j) { v[j] = xr[lane + 64 * j]; s += v[j].x * v[j].x + v[j].y * v[j].y + v[j].z * v[j].z + v[j].w * v[j].w; }
    s = wave_sum(s);
    const float r = rsqrtf(s * (1.f / D_MODEL) + EPS);
#pragma unroll
    for (int j = 0; j < 4; ++j) { const float4 w = ((const float4*)fw)[lane + 64 * j]; xr[lane + 64 * j] = make_float4(v[j].x * r * w.x, v[j].y * r * w.y, v[j].z * r * w.z, v[j].w * r * w.w); }
}

extern "C" void kernel_launch(void* const* d_in, const int* in_sizes, int n_in, void* d_out, int out_size, void* d_ws, size_t ws_size, hipStream_t stream) {
    const float* x = (const float*)d_in[0];
    const float* norm_mix_w = (const float*)d_in[1]; const float* w_in = (const float*)d_in[2]; const float* q_norm_w = (const float*)d_in[3]; const float* k_norm_w = (const float*)d_in[4];
    const float* conv_w = (const float*)d_in[5]; const float* conv_b = (const float*)d_in[6]; const float* dt_bias = (const float*)d_in[7]; const float* a_log = (const float*)d_in[8];
    const float* d_skip = (const float*)d_in[9]; const float* ssd_norm_w = (const float*)d_in[10]; const float* w_out = (const float*)d_in[11]; const float* norm_ffn_w = (const float*)d_in[12];
    const float* w_gate = (const float*)d_in[13]; const float* w_up = (const float*)d_in[14]; const float* w_down = (const float*)d_in[15]; const float* final_norm_w = (const float*)d_in[16];
    float* out = (float*)d_out; unsigned char* ws = (unsigned char*)d_ws;
    float* SSQ = (float*)(ws + WS_SSQ); float* DT = (float*)(ws + WS_DT); float* RSTD = (float*)(ws + WS_RSTD); float* ROPE = (float*)(ws + WS_ROPE);
    bf16* XN = (bf16*)(ws + WS_XN); bf16* MIX = (bf16*)(ws + WS_MIX); bf16* Q = (bf16*)(ws + WS_Q); bf16* Kb = (bf16*)(ws + WS_K); bf16* Vb = (bf16*)(ws + WS_V);
    bf16* Z = (bf16*)(ws + WS_Z); bf16* XR = (bf16*)(ws + WS_XBCR); bf16* XB = (bf16*)(ws + WS_XBC); bf16* HFF = (bf16*)(ws + WS_HFF);
    float* TMP = (float*)(ws + WS_TMP); float* Y0 = (float*)(ws + WS_ST); float* Y1 = (float*)(ws + WS_XBCR);
    k_rope_tab<<<4, 256, 0, stream>>>(ROPE);
    k_prep<<<M / 4, 256, 0, stream>>>(x, XN, SSQ, RSTD);
    for (int l = 0; l < DEPTH; ++l) {
        const float* res = l == 0 ? x : out;
        for (int ch = 0; ch < 8; ++ch) {
            k_ngemm<1, EpiProj><<<dim3((NIN + 63) / 64, 4096 / 64), 256, 0, stream>>>(XN + (size_t)ch * 4096 * D_MODEL, D_MODEL, w_in + (size_t)l * D_MODEL * NIN, nullptr, NIN, norm_mix_w + l * D_MODEL, NIN, D_MODEL, EpiProj{TMP, RSTD, ch * 4096});
            k_post<<<4096 / 4, 256, 0, stream>>>(TMP, ch * 4096, q_norm_w + l * 64, k_norm_w + l * 64, ROPE, Q, Kb, Vb, Z, XR, DT);
        }
        k_attn<<<BATCH * 8 * 16, 256, 0, stream>>>(Q, Kb, Vb, MIX);
        k_conv<<<M * 4, 256, 0, stream>>>(XR, conv_w + (size_t)l * 5 * NCONV, conv_b + l * NCONV, XB);
        k_scan<<<BATCH * 8 * 2, 256, 0, stream>>>(XB, DT, dt_bias + l * 16, a_log + l * 16, Y0, Y1);
        k_comb<<<M * 2 / 4, 256, 0, stream>>>(Y0, Y1, XB, Z, d_skip + l * 8, ssd_norm_w + l * NSSD, MIX);
        k_ngemm<1, EpiRes><<<dim3(D_MODEL / 64, M / 64), 256, 0, stream>>>(MIX, D_MODEL, w_out + (size_t)l * D_MODEL * D_MODEL, nullptr, D_MODEL, nullptr, D_MODEL, D_MODEL, EpiRes{res, out});
        k_prep<<<M / 4, 256, 0, stream>>>(out, XN, SSQ, RSTD);
        k_ngemm<2, EpiSwiglu><<<dim3(DFF / 64, M / 64), 256, 0, stream>>>(XN, D_MODEL, w_gate + (size_t)l * D_MODEL * DFF, w_up + (size_t)l * D_MODEL * DFF, DFF, norm_ffn_w + l * D_MODEL, DFF, D_MODEL, EpiSwiglu{HFF, RSTD});
        k_ngemm<1, EpiRes><<<dim3(D_MODEL / 64, M / 64), 256, 0, stream>>>(HFF, DFF, w_down + (size_t)l * DFF * D_MODEL, nullptr, D_MODEL, nullptr, D_MODEL, DFF, EpiRes{out, out});
        k_prep<<<M / 4, 256, 0, stream>>>(out, XN, SSQ, RSTD);
    }
    k_final<<<M / 4, 256, 0, stream>>>(out, final_norm_w);
}
```

```cpp
#include <hip/hip_runtime.h>
#include <cstdint>
#include <cstdio>

constexpr int D_MODEL = 1024, BATCH = 8, SEQ = 4096, DEPTH = 2, M = BATCH * SEQ;
constexpr int NQ = 512, NKV = 128, NSSD = 512, NCONV = 1024, NIN = 2320, NINM = 2304;
constexpr int DFF = 2816, NGU = 2 * DFF;
constexpr float EPS = 1e-6f;
constexpr float C2 = 0.125f * 1.4426950408889634f;

constexpr size_t MiB = 1u << 20;
constexpr size_t WS_CTL = 0, CTL_ZERO_BYTES = 1 * MiB;
constexpr size_t WS_SSQ = 1 * MiB;
constexpr size_t WS_DT = 3 * MiB;
constexpr size_t WS_CD = 5 * MiB;
constexpr size_t WS_ROPE = 5 * MiB + 512 * 1024;
constexpr size_t WS_WIN = 6 * MiB;
constexpr size_t WS_WDT = 15 * MiB;
constexpr size_t WS_WOUT = 16 * MiB;
constexpr size_t WS_WGU = 20 * MiB;
constexpr size_t WS_WDN = 42 * MiB;
constexpr size_t WS_XN = 56 * MiB;
constexpr size_t WS_MIX = 120 * MiB;
constexpr size_t WS_Q = 184 * MiB;
constexpr size_t WS_K = 216 * MiB;
constexpr size_t WS_V = 224 * MiB;
constexpr size_t WS_Z = 232 * MiB;
constexpr size_t WS_XBCR = 264 * MiB;
constexpr size_t WS_XBC = 328 * MiB;
constexpr size_t WS_ST = 392 * MiB;
constexpr size_t WS_HFF = 184 * MiB;
constexpr size_t WS_TMP = 456 * MiB;
constexpr size_t WS_YD = 456 * MiB;
constexpr size_t WS_CIMG = 328 * MiB;
constexpr size_t WS_EX = 328 * MiB + 16 * MiB;
constexpr int CW_BAR = 4096;

#ifdef LOOP_ALIGN
#define LOOP_ALIGN_STR2(x) #x
#define LOOP_ALIGN_STR1(x) LOOP_ALIGN_STR2(x)
#define LOOP_ALIGN_STR LOOP_ALIGN_STR1(LOOP_ALIGN)
#endif
__device__ __forceinline__ int mk_lane() { int l; asm volatile("v_mbcnt_lo_u32_b32 %0, -1, 0\n\tv_mbcnt_hi_u32_b32 %0, -1, %0" : "=v"(l)); return l; }
namespace pg8 {
#define PG8_LAS __attribute__((address_space(3)))
typedef unsigned short bf16_t;
typedef short bf16x8 __attribute__((ext_vector_type(8)));
typedef float f32x4 __attribute__((ext_vector_type(4)));
typedef unsigned u32x4 __attribute__((ext_vector_type(4)));
constexpr int BM = 256, BK = 64, HALF = 128, HTB = HALF * BK * 2  , STAGE_BYTES = 8 * HTB, NXCD = 8, WGM = 8;

__host__ __device__ __forceinline__ int lds_byte(int r, int c) { const int st = (r >> 4) * 2 + (c >> 5), rr = r & 15, cc = c & 31, ob = rr * 64 + cc * 2; return st * 1024 + (ob ^ (((ob >> 9) & 1) << 5)); }
__host__ __device__ __forceinline__ void stage_rc(int b, int& R, int& C) { const int st = b / 1024, sb = b % 1024, swz = sb ^ (((sb >> 9) & 1) << 5); R = (st >> 1) * 16 + swz / 64; C = (st & 1) * 32 + (swz % 64) / 2; }
__host__ __device__ __forceinline__ int perm32(int rho) { const int n = rho >> 4, i = rho & 15; return 8 * (i >> 2) + 4 * n + (i & 3); }

struct Unit { int pm, pn, ord; };
struct Gemm { const bf16_t* A; const bf16_t* Bt; int M, N, K; };

struct StaticOrder {
    int nM, nN, nwg, G, c, wgm;
    __host__ __device__ void init(int M, int N, int G_, int c_, int wgm_ = WGM) { nM = M / BM; nN = N / BM; nwg = nM * nN; G = G_; c = c_; wgm = wgm_; }
    __host__ __device__ bool next(int i, Unit& u) const {
        const long L = (long)i * G + c; if (L >= nwg) return false;
        int wgid = (int)L; { const int q = nwg / NXCD, r = nwg % NXCD, xcd = wgid % NXCD, off = wgid / NXCD; wgid = (xcd < r ? xcd * (q + 1) : r * (q + 1) + (xcd - r) * q) + off; }
        const int nig = wgm * nN, gid = wgid / nig, fm = gid * wgm, gsz = (nM - fm) < wgm ? (nM - fm) : wgm;
        u.pm = fm + ((wgid % nig) % gsz); u.pn = (wgid % nig) / gsz; return true;
    }
    __device__ __forceinline__ void a_ready(const Unit&) const {}
    __device__ __forceinline__ void done(const Unit&) const {}
};

__device__ __forceinline__ unsigned cvt_pk_bf16(float lo, float hi) { unsigned r; asm volatile("v_cvt_pk_bf16_f32 %0, %1, %2" : "=v"(r) : "v"(lo), "v"(hi)); return r; }
typedef float f32x2 __attribute__((ext_vector_type(2)));
typedef unsigned u32x2 __attribute__((ext_vector_type(2)));
__device__ __forceinline__ float sum_fq(float s) {
    { const auto r = __builtin_amdgcn_permlane16_swap(__float_as_uint(s), __float_as_uint(s), false, false); s = __uint_as_float(r[0]) + __uint_as_float(r[1]); }
    { const auto r = __builtin_amdgcn_permlane32_swap(__float_as_uint(s), __float_as_uint(s), false, false); s = __uint_as_float(r[0]) + __uint_as_float(r[1]); }
    return s;
}
__device__ __forceinline__ void rows_rstd(float (&rs)[2][4], const float* __restrict__ SSQ, int row0, int fq) {
    f32x4 p[2][4];
#pragma unroll
    for (int ai = 0; ai < 2; ++ai)
#pragma unroll
        for (int m = 0; m < 4; ++m) p[ai][m] = *(const f32x4*)(SSQ + (size_t)(row0 + ai * HALF + m * 16) * 16 + 4 * fq);
#pragma unroll
    for (int ai = 0; ai < 2; ++ai)
#pragma unroll
        for (int m = 0; m < 4; ++m) { const float s = sum_fq((p[ai][m][0] + p[ai][m][1]) + (p[ai][m][2] + p[ai][m][3])); rs[ai][m] = rsqrtf(s * (1.0f / 1024.0f) + EPS); }
}
struct OrdOrder : StaticOrder { __host__ __device__ bool next(int i, Unit& u) const { const bool ok = StaticOrder::next(i, u); u.ord = i; return ok; } };
__device__ __forceinline__ void rows_rstd_lds(float (&rs)[2][4], const PG8_LAS float* rst, const Unit& u, int wr, int fr) {
    const PG8_LAS float* p = rst + u.ord * 256 + wr * 64 + fr;
#pragma unroll
    for (int ai = 0; ai < 2; ++ai)
#pragma unroll
        for (int m = 0; m < 4; ++m) rs[ai][m] = p[ai * HALF + m * 16];
}
#ifndef OPT_TILEMAP
#define OPT_TILEMAP 1
#endif
__host__ __device__ __forceinline__ int inproj_ltile(int pn) { return OPT_TILEMAP ? (int)((0x872654130ULL >> (4 * pn)) & 15ULL) : pn; }
struct EpiInProj {
    static constexpr bool PERM = true, AFTER_DRAIN = false;
    bf16_t *Q, *Kb, *Vb, *Z, *XR; const PG8_LAS float *rst, *qkw; const PG8_LAS float* tab; int var;
    __device__ __forceinline__ void operator()(const f32x4 (&acc)[2][2][4][2], const Unit& u, int wr, int wc, int fr, int fq) const {
        if (var == 3) return;
        const int row0 = u.pm * BM + wr * 64 + fr, lp = inproj_ltile(u.pn);
        float rs[2][4]; rows_rstd_lds(rs, rst, u, wr, fr);
        if (lp >= 3) {
            bf16_t* base; int ld;
            if (lp < 5) { base = Z + (lp - 3) * 256; ld = NSSD; } else { base = XR + (lp - 5) * 256; ld = NCONV; }
            base += wc * 32 + 8 * fq;
#pragma unroll
            for (int ai = 0; ai < 2; ++ai)
#pragma unroll
                for (int m = 0; m < 4; ++m) { const int row = row0 + ai * HALF + m * 16; const float r = rs[ai][m]; bf16_t* rp = base + (size_t)row * ld;
#pragma unroll
                    for (int bj = 0; bj < 2; ++bj) { const f32x4 v0 = acc[ai][bj][m][0] * r, v1 = acc[ai][bj][m][1] * r; u32x4 w; w.x = cvt_pk_bf16(v0[0], v0[1]); w.y = cvt_pk_bf16(v0[2], v0[3]); w.z = cvt_pk_bf16(v1[0], v1[1]); w.w = cvt_pk_bf16(v1[2], v1[3]);
                        if (var == 4 && bj == 1) asm volatile("" :: "v"(w)); else if (var == 5) asm volatile("" :: "v"(w)); else *(u32x4*)(rp + bj * HALF) = w; } }
        } else if (lp == 2 && wc >= 2) {
            bf16_t* base = Vb + (wc - 2) * 64 + 4 * fq;
#pragma unroll
            for (int ai = 0; ai < 2; ++ai)
#pragma unroll
                for (int m = 0; m < 4; ++m) { const int row = row0 + ai * HALF + m * 16; const float r = rs[ai][m]; bf16_t* rp = base + (size_t)row * NKV;
#pragma unroll
                    for (int bj = 0; bj < 2; ++bj)
#pragma unroll
                        for (int n = 0; n < 2; ++n) { const f32x4 v = acc[ai][bj][m][n] * r; u32x2 w; w.x = cvt_pk_bf16(v[0], v[1]); w.y = cvt_pk_bf16(v[2], v[3]); if (var == 6) asm volatile("" :: "v"(w)); else *(u32x2*)(rp + 32 * bj + 16 * n) = w; } }
        } else {
            const bool isq = lp < 2; const PG8_LAS float* wp = isq ? qkw : qkw + 64; const float osc = isq ? C2 : 1.0f;
            bf16_t* base = isq ? Q + (lp * 4 + wc) * 64 + 4 * fq : Kb + wc * 64 + 4 * fq; const int ld = isq ? NQ : NKV;
            f32x4 wv[2][2];
#pragma unroll
            for (int bj = 0; bj < 2; ++bj)
#pragma unroll
                for (int n = 0; n < 2; ++n) wv[bj][n] = *(const PG8_LAS f32x4*)(wp + 32 * bj + 16 * n + 4 * fq) * osc;
            const int p0 = (u.pm * 4 + wr) & 63;
#pragma unroll
            for (int ai = 0; ai < 2; ++ai) {
                const f32x4 c0 = *(const PG8_LAS f32x4*)(tab + (p0 + 2 * ai) * 16 + 4 * fq), s0 = *(const PG8_LAS f32x4*)(tab + 1024 + (p0 + 2 * ai) * 16 + 4 * fq);
#pragma unroll
                for (int mh = 0; mh < 2; ++mh) {
                    f32x4 c1[2], s1[2];
#pragma unroll
                    for (int mm = 0; mm < 2; ++mm) { c1[mm] = *(const PG8_LAS f32x4*)(tab + (fr + 32 * mh + 16 * mm) * 16 + 4 * fq); s1[mm] = *(const PG8_LAS f32x4*)(tab + 1024 + (fr + 32 * mh + 16 * mm) * 16 + 4 * fq); }
#pragma unroll
                    for (int mm = 0; mm < 2; ++mm) { const int m = 2 * mh + mm, row = row0 + ai * HALF + m * 16; const float r = rs[ai][m]; bf16_t* rp = base + (size_t)row * ld;
                        float ss = 0.f;
#pragma unroll
                        for (int bj = 0; bj < 2; ++bj)
#pragma unroll
                            for (int n = 0; n < 2; ++n) { const f32x4 q2 = acc[ai][bj][m][n] * acc[ai][bj][m][n]; ss += (q2[0] + q2[1]) + (q2[2] + q2[3]); }
                        ss = sum_fq(ss);
                        const float sc = r * rsqrtf(ss * (r * r) * (1.0f / 64.0f) + EPS);
#pragma unroll
                        for (int bj = 0; bj < 2; ++bj) {
                            const f32x4 cs = (bj ? c1[mm] : c0) * sc, sn = (bj ? s1[mm] : s0) * sc;
                            const f32x4 y0 = acc[ai][bj][m][0] * wv[bj][0], y1 = acc[ai][bj][m][1] * wv[bj][1];
                            const f32x4 o0 = y0 * cs - y1 * sn, o1 = y1 * cs + y0 * sn;
                            u32x2 w0, w1; w0.x = cvt_pk_bf16(o0[0], o0[1]); w0.y = cvt_pk_bf16(o0[2], o0[3]); w1.x = cvt_pk_bf16(o1[0], o1[1]); w1.y = cvt_pk_bf16(o1[2], o1[3]);
                            if (var == 6) asm volatile("" :: "v"(w0), "v"(w1)); else { *(u32x2*)(rp + 32 * bj) = w0; *(u32x2*)(rp + 32 * bj + 16) = w1; } } } } }
        }
    }
};
struct EpiResid {
    static constexpr bool PERM = true, AFTER_DRAIN = false;
    const float* resf; bf16_t* XN; float* SSQ;
    __device__ __forceinline__ void operator()(const f32x4 (&acc)[2][2][4][2], const Unit& u, int wr, int wc, int fr, int fq) const {
        const int row0 = u.pm * BM + wr * 64 + fr, col0 = u.pn * BM + wc * 32 + 8 * fq;
#pragma unroll
        for (int ai = 0; ai < 2; ++ai) {
            f32x4 r[4][2][2];
            if (resf) {
#pragma unroll
                for (int m = 0; m < 4; ++m)
#pragma unroll
                    for (int bj = 0; bj < 2; ++bj) { const float* p = resf + (size_t)(row0 + ai * HALF + m * 16) * D_MODEL + col0 + bj * HALF; r[m][bj][0] = *(const f32x4*)p; r[m][bj][1] = *(const f32x4*)(p + 4); }
            } else {
                u32x4 w[4][2];
#pragma unroll
                for (int m = 0; m < 4; ++m)
#pragma unroll
                    for (int bj = 0; bj < 2; ++bj) w[m][bj] = *(const u32x4*)(XN + (size_t)(row0 + ai * HALF + m * 16) * D_MODEL + col0 + bj * HALF);
#pragma unroll
                for (int m = 0; m < 4; ++m)
#pragma unroll
                    for (int bj = 0; bj < 2; ++bj) { const u32x4 x = w[m][bj];
                        r[m][bj][0] = (f32x4){__uint_as_float(x.x << 16), __uint_as_float(x.x & 0xffff0000u), __uint_as_float(x.y << 16), __uint_as_float(x.y & 0xffff0000u)};
                        r[m][bj][1] = (f32x4){__uint_as_float(x.z << 16), __uint_as_float(x.z & 0xffff0000u), __uint_as_float(x.w << 16), __uint_as_float(x.w & 0xffff0000u)}; }
            }
#pragma unroll
            for (int m = 0; m < 4; ++m) { const int row = row0 + ai * HALF + m * 16; const size_t off = (size_t)row * D_MODEL + col0; float ss = 0.f;
#pragma unroll
                for (int bj = 0; bj < 2; ++bj) { const f32x4 x0 = r[m][bj][0] + acc[ai][bj][m][0], x1 = r[m][bj][1] + acc[ai][bj][m][1];
                    const f32x4 q0 = x0 * x0, q1 = x1 * x1; ss += ((q0[0] + q0[1]) + (q0[2] + q0[3])) + ((q1[0] + q1[1]) + (q1[2] + q1[3]));
                    u32x4 w; w.x = cvt_pk_bf16(x0[0], x0[1]); w.y = cvt_pk_bf16(x0[2], x0[3]); w.z = cvt_pk_bf16(x1[0], x1[1]); w.w = cvt_pk_bf16(x1[2], x1[3]);
                    *(u32x4*)(XN + off + bj * HALF) = w; }
                ss = sum_fq(ss);
                if (fq == 0) SSQ[(size_t)row * 16 + u.pn * 4 + wc] = ss; }
        }
    }
};
#ifndef OPT_NT_H
#define OPT_NT_H 0
#endif
#if OPT_NT_H
#define EPI_STORE16(p, v) __builtin_nontemporal_store((v), (u32x4*)(p))
#else
#define EPI_STORE16(p, v) (*(u32x4*)(p) = (v))
#endif
struct EpiSwiglu {
    static constexpr bool PERM = true, AFTER_DRAIN = false;
    bf16_t* H; const PG8_LAS float* rst; int var;
    __device__ __forceinline__ void operator()(const f32x4 (&acc)[2][2][4][2], const Unit& u, int wr, int wc, int fr, int fq) const {
        if (var == 3) return;
        const int row0 = u.pm * BM + wr * 64 + fr, col0 = u.pn * HALF + wc * 32 + 8 * fq;
        float rs[2][4];
        if (var == 1) {
#pragma unroll
            for (int ai = 0; ai < 2; ++ai)
#pragma unroll
                for (int m = 0; m < 4; ++m) rs[ai][m] = 1.0f;
        } else rows_rstd_lds(rs, rst, u, wr, fr);
#pragma unroll
        for (int ai = 0; ai < 2; ++ai)
#pragma unroll
            for (int m = 0; m < 4; ++m) { const int row = row0 + ai * HALF + m * 16; const float r = rs[ai][m]; unsigned w[4];
#pragma unroll
                for (int n = 0; n < 2; ++n) { const f32x4 g = acc[ai][0][m][n] * r, up = acc[ai][1][m][n] * r; float h[4];
#pragma unroll
                    for (int i = 0; i < 4; ++i) h[i] = g[i] * __builtin_amdgcn_rcpf(1.0f + __builtin_amdgcn_exp2f(-1.4426950408889634f * g[i])) * up[i];
                    w[2 * n] = cvt_pk_bf16(h[0], h[1]); w[2 * n + 1] = cvt_pk_bf16(h[2], h[3]); }
                u32x4 wv; wv.x = w[0]; wv.y = w[1]; wv.z = w[2]; wv.w = w[3];
                if (var == 2) asm volatile("" :: "v"(wv)); else EPI_STORE16(H + (size_t)row * DFF + col0, wv); }
    }
};
template <class Epi, class Sched, bool ALIGN_EPI = false, bool SP2 = false>
__device__ __forceinline__ void gemm_phase(PG8_LAS unsigned char* lds, const Gemm g, const Sched& S, const Epi& E, const int wave_id) {
    const int tid_ = wave_id * 64 + mk_lane();
    const int tid = tid_, wid = __builtin_amdgcn_readfirstlane(tid >> 6), lane = tid & 63, wr = wid >> 2, wc = wid & 3, fr = lane & 15, fq = lane >> 4;
    const int K = g.K, nt = K / BK;
    unsigned voffA[2], voffB[2];
#pragma unroll
    for (int i = 0; i < 2; ++i) { int R, C; stage_rc(tid * 16 + i * 8192, R, C); const int Rb = Epi::PERM ? ((R & ~31) + perm32(R & 31)) : R;
        voffA[i] = (unsigned)(R * K + C) * 2u; voffB[i] = (unsigned)(Rb * K + C) * 2u; }
    const size_t kstep = (size_t)(BK * 2);
    const size_t hstep = (size_t)HALF * K * 2;
    const size_t tstep = 2 * hstep;
    const unsigned ldsw = (unsigned)wid * 1024u;
    const int aoff = lds_byte(wr * 64 + fr, fq * 8), boff = lds_byte(wc * 32 + fr, fq * 8);
#define PG8_SA(b, h) (((b) * 2 + (h)) * HTB)
#define PG8_SB(b, h) ((4 + (b) * 2 + (h)) * HTB)
#define PG8_STAGE(bufoff, gbase, voff) do { _Pragma("unroll") for (int _i = 0; _i < 2; ++_i) \
        __builtin_amdgcn_global_load_lds((const unsigned*)((const char*)(gbase) + (voff)[_i]), (PG8_LAS unsigned*)(lds + (bufoff) + ldsw + _i * 8192), 16, 0, 0); } while (0)
#define PG8_LDA(dst, b, h) do { _Pragma("unroll") for (int m = 0; m < 4; ++m) _Pragma("unroll") for (int k = 0; k < 2; ++k) dst[m][k] = *(const PG8_LAS bf16x8*)(lds + PG8_SA(b, h) + aoff + m * 2048 + k * 1024); } while (0)
#define PG8_LDB(dst, b, h) do { _Pragma("unroll") for (int n = 0; n < 2; ++n) _Pragma("unroll") for (int k = 0; k < 2; ++k) dst[n][k] = *(const PG8_LAS bf16x8*)(lds + PG8_SB(b, h) + boff + n * 2048 + k * 1024); } while (0)
#define PG8_MMA(ai, bj, At, Bt) do { __builtin_amdgcn_s_setprio(1); _Pragma("unroll") for (int m = 0; m < 4; ++m) _Pragma("unroll") for (int n = 0; n < 2; ++n) _Pragma("unroll") for (int k = 0; k < 2; ++k) \
        acc[ai][bj][m][n] = __builtin_amdgcn_mfma_f32_16x16x32_bf16(Bt[n][k], At[m][k], acc[ai][bj][m][n], 0, 0, 0); __builtin_amdgcn_s_setprio(0); } while (0)
#define PG8_WAIT_V(n) asm volatile("s_waitcnt vmcnt(" #n ")" ::: "memory")
#define PG8_WAIT_L(n) asm volatile("s_waitcnt lgkmcnt(" #n ")" ::: "memory")
#define PG8_BAR __builtin_amdgcn_s_barrier()
#define PG8_SCHED __builtin_amdgcn_sched_barrier(0)
    Unit cur, nxt; int ui = 0;
    if (!S.next(0, cur)) return;
    f32x4 acc[2][2][4][2];
    float zf = 0.f; asm volatile("" : "+v"(zf));
#pragma unroll
    for (int a = 0; a < 2; ++a)
#pragma unroll
        for (int b = 0; b < 2; ++b)
#pragma unroll
            for (int m = 0; m < 4; ++m)
#pragma unroll
                for (int n = 0; n < 2; ++n) acc[a][b][m][n] = (f32x4){zf, zf, zf, zf};
    bf16x8 At[4][2], B0[2][2], B1[2][2];
    const char* cA = (const char*)g.A + (size_t)cur.pm * tstep; const char* cB = (const char*)g.Bt + (size_t)cur.pn * tstep;
    S.a_ready(cur);
    if constexpr (SP2) {
        PG8_STAGE(PG8_SB(0, 0), cB, voffB); PG8_STAGE(PG8_SB(0, 1), cB + hstep, voffB); PG8_STAGE(PG8_SA(0, 0), cA, voffA); PG8_STAGE(PG8_SA(0, 1), cA + hstep, voffA);
        if (wr == 1) PG8_BAR;
        PG8_WAIT_V(2); PG8_BAR;
        PG8_STAGE(PG8_SB(1, 0), cB + kstep, voffB); PG8_STAGE(PG8_SA(1, 0), cA + kstep, voffA); PG8_STAGE(PG8_SB(1, 1), cB + hstep + kstep, voffB);
        PG8_WAIT_V(6); PG8_BAR;
    } else {
        PG8_STAGE(PG8_SB(0, 0), cB, voffB); PG8_STAGE(PG8_SA(0, 0), cA, voffA); PG8_STAGE(PG8_SB(0, 1), cB + hstep, voffB); PG8_STAGE(PG8_SA(0, 1), cA + hstep, voffA);
        if (wr == 1) PG8_BAR;
        PG8_WAIT_V(4); PG8_BAR;
        PG8_STAGE(PG8_SB(1, 0), cB + kstep, voffB); PG8_STAGE(PG8_SA(1, 0), cA + kstep, voffA); PG8_STAGE(PG8_SB(1, 1), cB + hstep + kstep, voffB);
        PG8_WAIT_V(6); PG8_BAR;
    }
    for (;;) {
        const bool has_next = S.next(ui + 1, nxt);
        const char* nA = has_next ? (const char*)g.A + (size_t)nxt.pm * tstep : cA; const char* nB = has_next ? (const char*)g.Bt + (size_t)nxt.pn * tstep : cB;
#ifdef LOOP_ALIGN
        asm volatile(".p2align " LOOP_ALIGN_STR);
#endif
        for (int t = 0; t < nt; t += 2) {
            const bool last = (t == nt - 2);
            const char* a1 = cA + (size_t)(t + 1) * kstep;
            const char* a2 = last ? nA : cA + (size_t)(t + 2) * kstep; const char* b2 = last ? nB : cB + (size_t)(t + 2) * kstep;
            const char* a3 = a2 + kstep; const char* b3 = b2 + kstep;
            if (last && has_next) S.a_ready(nxt);
            if constexpr (SP2) {
            PG8_LDB(B0, 0, 0); PG8_LDB(B1, 0, 1); PG8_SCHED; PG8_LDA(At, 0, 0); PG8_STAGE(PG8_SA(1, 1), a1 + hstep, voffA);
            PG8_WAIT_V(8); PG8_WAIT_L(0); PG8_BAR; PG8_MMA(0, 0, At, B0); PG8_MMA(0, 1, At, B1); PG8_BAR; PG8_SCHED;
            PG8_LDA(At, 0, 1); PG8_STAGE(PG8_SB(0, 0), b2, voffB); PG8_STAGE(PG8_SB(0, 1), b2 + hstep, voffB); PG8_STAGE(PG8_SA(0, 0), a2, voffA);
            PG8_WAIT_V(8); PG8_WAIT_L(0); PG8_BAR; PG8_MMA(1, 0, At, B0); PG8_MMA(1, 1, At, B1); PG8_BAR; PG8_SCHED;
            PG8_LDB(B0, 1, 0); PG8_LDB(B1, 1, 1); PG8_SCHED; PG8_LDA(At, 1, 0); PG8_STAGE(PG8_SA(0, 1), a2 + hstep, voffA);
            PG8_WAIT_V(8); PG8_WAIT_L(0); PG8_BAR; PG8_MMA(0, 0, At, B0); PG8_MMA(0, 1, At, B1); PG8_BAR; PG8_SCHED;
            PG8_LDA(At, 1, 1); PG8_STAGE(PG8_SB(1, 0), b3, voffB); PG8_STAGE(PG8_SB(1, 1), b3 + hstep, voffB); PG8_STAGE(PG8_SA(1, 0), a3, voffA);
            PG8_WAIT_V(8); PG8_WAIT_L(0); PG8_BAR; PG8_MMA(1, 0, At, B0); PG8_MMA(1, 1, At, B1); PG8_BAR; PG8_SCHED;
            } else {
            PG8_LDB(B0, 0, 0); PG8_SCHED; PG8_LDA(At, 0, 0); PG8_STAGE(PG8_SA(1, 1), a1 + hstep, voffA);
            PG8_WAIT_L(8); PG8_BAR; PG8_WAIT_L(0); PG8_MMA(0, 0, At, B0); PG8_BAR; PG8_SCHED;
            PG8_LDB(B1, 0, 1); PG8_STAGE(PG8_SB(0, 0), b2, voffB);
            PG8_BAR; PG8_WAIT_L(0); PG8_MMA(0, 1, At, B1); PG8_BAR;
            PG8_LDA(At, 0, 1); PG8_STAGE(PG8_SA(0, 0), a2, voffA);
            PG8_BAR; PG8_WAIT_L(0); PG8_MMA(1, 0, At, B0); PG8_BAR; PG8_SCHED;
            PG8_STAGE(PG8_SB(0, 1), b2 + hstep, voffB);
            PG8_WAIT_V(6); PG8_BAR; PG8_MMA(1, 1, At, B1); PG8_BAR;
            PG8_LDB(B0, 1, 0); PG8_SCHED; PG8_LDA(At, 1, 0); PG8_STAGE(PG8_SA(0, 1), a2 + hstep, voffA);
            PG8_WAIT_L(8); PG8_BAR; PG8_WAIT_L(0); PG8_MMA(0, 0, At, B0); PG8_BAR; PG8_SCHED;
            PG8_LDB(B1, 1, 1); PG8_STAGE(PG8_SB(1, 0), b3, voffB);
            PG8_BAR; PG8_WAIT_L(0); PG8_MMA(0, 1, At, B1); PG8_BAR;
            PG8_LDA(At, 1, 1); PG8_STAGE(PG8_SA(1, 0), a3, voffA);
            PG8_BAR; PG8_WAIT_L(0); PG8_MMA(1, 0, At, B0); PG8_BAR; PG8_SCHED;
            PG8_STAGE(PG8_SB(1, 1), b3 + hstep, voffB);
            PG8_WAIT_V(6); PG8_BAR; PG8_MMA(1, 1, At, B1); PG8_BAR;
            }
        }
        if constexpr (ALIGN_EPI) { if (wr == 0) PG8_BAR; }
        if constexpr (!Epi::AFTER_DRAIN) { E(acc, cur, wr, wc, fr, fq); S.done(cur); }
        if (!has_next) break;
        asm volatile("" : "+v"(zf));
#pragma unroll
        for (int a = 0; a < 2; ++a)
#pragma unroll
            for (int b = 0; b < 2; ++b)
#pragma unroll
                for (int m = 0; m < 4; ++m)
#pragma unroll
                    for (int n = 0; n < 2; ++n) acc[a][b][m][n] = (f32x4){zf, zf, zf, zf};
        cur = nxt; cA = nA; cB = nB; ++ui;
        if constexpr (ALIGN_EPI) { if (wr == 1) PG8_BAR; }
    }
    PG8_WAIT_V(0);
    if constexpr (!ALIGN_EPI) { if (wr == 0) PG8_BAR; }
    PG8_BAR;
    if constexpr (Epi::AFTER_DRAIN) { E.fused(acc, cur, wr, wc, fr, fq, lds, wid, lane); S.done(cur); }
#undef PG8_SA
#undef PG8_SB
#undef PG8_STAGE
#undef PG8_LDA
#undef PG8_LDB
#undef PG8_MMA
#undef PG8_WAIT_V
#undef PG8_WAIT_L
#undef PG8_BAR
#undef PG8_SCHED
}
}

#define GAS __attribute__((address_space(1)))
#define LAS __attribute__((address_space(3)))
typedef unsigned short bf16;
typedef unsigned v4u __attribute__((ext_vector_type(4)));
typedef float f32x4 __attribute__((ext_vector_type(4)));
typedef short bf16x8 __attribute__((ext_vector_type(8)));
typedef GAS unsigned gu32;
typedef GAS unsigned long long gu64;
#define RLX_AGENT __ATOMIC_RELAXED, __HIP_MEMORY_SCOPE_AGENT
#define LDS_WAIT() asm volatile("s_waitcnt lgkmcnt(0)" ::: "memory")
#define VM_WAIT() asm volatile("s_waitcnt vmcnt(0)" ::: "memory")
__device__ __forceinline__ unsigned long long rt() { return __builtin_amdgcn_s_memrealtime(); }
__device__ __forceinline__ unsigned f2bf(float f) { unsigned u = __builtin_bit_cast(unsigned, f); return (u + 0x7fffu + ((u >> 16) & 1u)) >> 16; }
__device__ __forceinline__ unsigned pk2(float lo, float hi) { return f2bf(lo) | (f2bf(hi) << 16); }

__device__ __forceinline__ float sfma(float a, float b, float c) { float r; asm("v_fma_f32 %0, %1, %2, %3" : "=v"(r) : "v"(a), "v"(b), "v"(c)); return r; }
__device__ __forceinline__ float smul(float a, float b) { float r; asm("v_mul_f32_e32 %0, %1, %2" : "=v"(r) : "v"(a), "v"(b)); return r; }
__device__ __forceinline__ f32x4 fma4(const f32x4 a, const f32x4 b, const f32x4 c) { f32x4 r; r[0] = sfma(a[0], b[0], c[0]); r[1] = sfma(a[1], b[1], c[1]); r[2] = sfma(a[2], b[2], c[2]); r[3] = sfma(a[3], b[3], c[3]); return r; }
__device__ __forceinline__ f32x4 mul4(const f32x4 a, const f32x4 b) { f32x4 r; r[0] = smul(a[0], b[0]); r[1] = smul(a[1], b[1]); r[2] = smul(a[2], b[2]); r[3] = smul(a[3], b[3]); return r; }
__device__ __forceinline__ f32x4 mul4s(const f32x4 a, const float s) { f32x4 r; r[0] = smul(a[0], s); r[1] = smul(a[1], s); r[2] = smul(a[2], s); r[3] = smul(a[3], s); return r; }
#define XB_TMO      128
#define XB_XCNT(j)  (256  + 64 * (j))
#define XB_XSUB(j)  (1280 + 64 * (j))
#define XB_XGEN(j)  (2304 + 64 * (j))
#define XB_TOP      3328
#define XB_TOPGEN   3392
#define XB_LSUB(j)  (3456 + 64 * (j))
#define XCD_BAR_WORDS 4480
#define XB_SPIN_CAP (1u << 18)

__device__ __forceinline__ unsigned xb_ld(unsigned* p)              { return __hip_atomic_load(p, __ATOMIC_RELAXED, __HIP_MEMORY_SCOPE_AGENT); }
__device__ __forceinline__ unsigned xb_add(unsigned* p, unsigned v) { return __hip_atomic_fetch_add(p, v, __ATOMIC_RELAXED, __HIP_MEMORY_SCOPE_AGENT); }
__device__ __forceinline__ unsigned xb_xcc_id() { return (unsigned)__builtin_amdgcn_s_getreg((3 << 11) | 20) & 0xFu; }
#define XB_SPIN(cond, bar) do { unsigned _sp = 0; while (cond) { __builtin_amdgcn_s_sleep(1); \
    if ((++_sp & 255u) == 0u) { if (xb_ld(&(bar)[XB_TMO])) break; if (_sp > XB_SPIN_CAP) { atomicAdd(&(bar)[XB_TMO], 1u); break; } } } } while (0)

struct XcdBarrier {
    unsigned* bar; unsigned x;
    volatile LAS unsigned* st;
};

__device__ __forceinline__ XcdBarrier xcd_barrier_post(unsigned* bar, volatile LAS unsigned* st) {
    XcdBarrier b; b.bar = bar; b.x = xb_xcc_id(); b.st = st;
    if (threadIdx.x == 0) st[3] = xb_add(&bar[XB_XCNT(b.x)], 1u);
    return b;
}
__device__ __forceinline__ unsigned xcd_barrier_complete(unsigned* bar, unsigned x, unsigned& nloc, unsigned& nx) {
    const unsigned G = gridDim.x * gridDim.y * gridDim.z;
    unsigned sum, cnt, mine, sp = 0u;
    for (;;) {
        sum = 0u; cnt = 0u; mine = 0u;
#pragma unroll
        for (unsigned j = 0; j < 16; ++j) { const unsigned c = xb_ld(&bar[XB_XCNT(j)]); sum += c; cnt += (c > 0u) ? 1u : 0u; mine = (j == x) ? c : mine; }
        if (sum == G) break;
        __builtin_amdgcn_s_sleep(1);
        if ((++sp & 255u) == 0u) { if (xb_ld(&bar[XB_TMO])) break; if (sp > XB_SPIN_CAP) { atomicAdd(&bar[XB_TMO], 1u); break; } }
    }
    nloc = mine > 0u ? mine : 1u; nx = cnt > 0u ? cnt : 1u;
    return sum;
}

__device__ __forceinline__ void xcd_barrier(const XcdBarrier& b) {
    asm volatile("s_waitcnt vmcnt(0)" ::: "memory");
    __syncthreads();
    if (threadIdx.x == 0) {
        unsigned* bar = b.bar;
        __builtin_amdgcn_s_waitcnt(0);
        unsigned nloc = b.st[0], nx = b.st[1];
        if (nloc == 0u) { const unsigned sum = xcd_barrier_complete(bar, b.x, nloc, nx); b.st[0] = nloc; b.st[1] = nx;
            const unsigned G = gridDim.x * gridDim.y * gridDim.z; bool uni = (sum == G) && (G % 8u == 0u) && nx == 8u;
#pragma unroll
            for (unsigned j = 0; j < 8; ++j) uni = uni && (xb_ld(&bar[XB_XCNT(j)]) == G / 8u);
            b.st[2] = uni ? 2u : 1u; }
        const unsigned old = xb_add(&bar[XB_XSUB(b.x)], 1u);
        const unsigned gen = old / nloc;
        if (old + 1u == (gen + 1u) * nloc) {
            __builtin_amdgcn_fence(__ATOMIC_RELEASE, "agent");
            asm volatile("s_waitcnt vmcnt(0)" ::: "memory");
            const unsigned og = xb_add(&bar[XB_TOP], 1u);
            const unsigned tg = og / nx;
            if (og + 1u == (tg + 1u) * nx) xb_add(&bar[XB_TOPGEN], 1u);
            else XB_SPIN(xb_ld(&bar[XB_TOPGEN]) == tg, bar);
            __builtin_amdgcn_fence(__ATOMIC_ACQUIRE, "agent");
            xb_add(&bar[XB_XGEN(b.x)], 1u);
            asm volatile("s_waitcnt vmcnt(0)" ::: "memory");
        } else {
            XB_SPIN(xb_ld(&bar[XB_XGEN(b.x)]) == gen, bar);
            __builtin_amdgcn_fence(__ATOMIC_ACQUIRE, "agent");
            asm volatile("s_waitcnt vmcnt(0)" ::: "memory");
        }
    }
    __syncthreads();
}

__device__ __forceinline__ void xcd_barrier_local(const XcdBarrier& b) {
    asm volatile("s_waitcnt vmcnt(0)" ::: "memory");
    __syncthreads();
    if (threadIdx.x == 0) {
        unsigned* bar = b.bar;
        __builtin_amdgcn_s_waitcnt(0);
        const unsigned nloc = b.st[0];
        const unsigned old = xb_add(&bar[XB_LSUB(b.x)], 1u);
        const unsigned target = (old / nloc + 1u) * nloc;
        XB_SPIN(xb_ld(&bar[XB_LSUB(b.x)]) < target, bar);
        __builtin_amdgcn_fence(__ATOMIC_ACQUIRE, "agent");
        asm volatile("s_waitcnt vmcnt(0)" ::: "memory");
    }
    __syncthreads();
}

__device__ __forceinline__ float bf2f(bf16 v) { return __uint_as_float((unsigned)v << 16); }
__device__ __forceinline__ float wave_sum(float v) {
#pragma unroll
    for (int o = 1; o < 64; o <<= 1) v += __shfl_xor(v, o);
    return v;
}
__device__ __forceinline__ float silu_f(float v) { return v / (1.f + __expf(-v)); }

#include <hip/hip_bf16.h>
#include <cmath>
namespace attn_body {
using bf16=__hip_bfloat16;
using bf16x8=__attribute__((ext_vector_type(8)))short;
using s16x4=__attribute__((ext_vector_type(4)))short;
using f32x16=__attribute__((ext_vector_type(16)))float;
using u32x4=__attribute__((ext_vector_type(4)))unsigned;
constexpr int SEQ=4096,D=64,PQ=512,PKV=128,PO=1024;
constexpr int NW=8,QBLK=32,QB=QBLK*NW,KVBLK=64,NQB=SEQ/QB;
constexpr int ATTN_UNIT_ROWS=QB;
__device__ __forceinline__ int crow(int r,int hi){return (r&3)+8*(r>>2)+4*hi;}
#define SBAR() __builtin_amdgcn_sched_barrier(0)
__device__ __forceinline__ void cmask(f32x16&p0,f32x16&p1,int jb,int qrel,int hi){
  const float NEG=-INFINITY; int kb=64*jb+4*hi;
  #pragma unroll
  for(int r=0;r<16;++r){int kv=kb+(r&3)+8*(r>>2); if(kv>qrel)p0[r]=NEG; if(kv+32>qrel)p1[r]=NEG;}
}

constexpr int NSLOT=3, SLOTB=8192;
constexpr int LDS_K=0, LDS_V=NSLOT*SLOTB, LDS_WS=2*NSLOT*SLOTB, LDS_OST=LDS_WS+NW*64*4, LDS_BYTES=LDS_OST+NW*4096;
constexpr float C2=0.125f*1.4426950408889634f;
__device__ __forceinline__ void glds16(const void*gsrc,unsigned lds_dst){unsigned keep;
  asm volatile("s_mov_b32 %0, m0\n\ts_mov_b32 m0, %2\n\ts_nop 0\n\tglobal_load_lds_dwordx4 %1, off\n\ts_mov_b32 m0, %0":"=&s"(keep):"v"(gsrc),"s"(lds_dst):"memory");}
__device__ __forceinline__ float max3f(float a,float b,float c){float r;asm("v_max3_f32 %0, %1, %2, %3":"=v"(r):"v"(a),"v"(b),"v"(c));return r;}
__device__ __forceinline__ float max2f(float a,float b){float r;asm("v_max_f32_e32 %0, %1, %2":"=v"(r):"v"(a),"v"(b));return r;}
__device__ __forceinline__ float fadd_s(float a,float b){float r;asm("v_add_f32_e32 %0, %1, %2":"=v"(r):"v"(a),"v"(b));return r;}
__device__ __forceinline__ float fsub_s(float a,float b){float r;asm("v_sub_f32_e32 %0, %1, %2":"=v"(r):"v"(a),"v"(b));return r;}
typedef float f32x2_t __attribute__((ext_vector_type(2))); typedef __bf16 bf16x2_t __attribute__((ext_vector_type(2)));
__device__ __forceinline__ unsigned cvtpk_s(float lo,float hi){f32x2_t v={lo,hi};bf16x2_t b=__builtin_convertvector(v,bf16x2_t);return __builtin_bit_cast(unsigned,b);}
#define WAIT_BAR(N) asm volatile("s_waitcnt vmcnt(" #N ") lgkmcnt(0)\n\ts_barrier":::"memory")

__device__ __forceinline__ void qkt(f32x16&p0,f32x16&p1,const char*Kslot,const bf16x8*qr,const f32x16&negm,int r32,int hi){
  const char*kb=Kslot+hi*1024+r32*16;
  #pragma unroll
  for(int d0=0;d0<4;++d0){
    const bf16x8 b0=*reinterpret_cast<const bf16x8*>(kb+d0*2048);
    const bf16x8 b1=*reinterpret_cast<const bf16x8*>(kb+d0*2048+512);
    if(d0==0){p0=__builtin_amdgcn_mfma_f32_32x32x16_bf16(b0,qr[0],negm,0,0,0);p1=__builtin_amdgcn_mfma_f32_32x32x16_bf16(b1,qr[0],negm,0,0,0);}
    else{p0=__builtin_amdgcn_mfma_f32_32x32x16_bf16(b0,qr[d0],p0,0,0,0);p1=__builtin_amdgcn_mfma_f32_32x32x16_bf16(b1,qr[d0],p1,0,0,0);}}
}
typedef __attribute__((address_space(3))) const char* lds_cptr;
typedef short v4i16_t __attribute__((ext_vector_type(4)));
__device__ __forceinline__ void kload8(bf16x8*kf,lds_cptr kp){
  kf[0]=*(const __attribute__((address_space(3))) bf16x8*)(kp);      kf[1]=*(const __attribute__((address_space(3))) bf16x8*)(kp+512);
  kf[2]=*(const __attribute__((address_space(3))) bf16x8*)(kp+2048); kf[3]=*(const __attribute__((address_space(3))) bf16x8*)(kp+2560);
  kf[4]=*(const __attribute__((address_space(3))) bf16x8*)(kp+4096); kf[5]=*(const __attribute__((address_space(3))) bf16x8*)(kp+4608);
  kf[6]=*(const __attribute__((address_space(3))) bf16x8*)(kp+6144); kf[7]=*(const __attribute__((address_space(3))) bf16x8*)(kp+6656);
}
__device__ __forceinline__ void kload2(bf16x8*kf,lds_cptr kp,int j){ kf[2*j]=*(const __attribute__((address_space(3))) bf16x8*)(kp+j*2048); kf[2*j+1]=*(const __attribute__((address_space(3))) bf16x8*)(kp+j*2048+512); }
__device__ __forceinline__ s16x4 vtr(lds_cptr p){ return __builtin_bit_cast(s16x4,__builtin_amdgcn_ds_read_tr16_b64_v4i16((__attribute__((address_space(3))) v4i16_t*)p)); }
__device__ __forceinline__ float rowmax(const f32x16&p0,const f32x16&p1){
  float a=max3f(p0[0],p0[1],p1[0]),b=max3f(p0[2],p0[3],p1[1]);a=max3f(a,p1[2],p1[3]);
  #pragma unroll
  for(int r=4;r<16;r+=4){a=max3f(a,p0[r],p0[r+1]);b=max3f(b,p0[r+2],p0[r+3]);a=max3f(a,p1[r],p1[r+1]);b=max3f(b,p1[r+2],p1[r+3]);}
  const float m=max2f(a,b);
  auto rr=__builtin_amdgcn_permlane32_swap(__float_as_uint(m),__float_as_uint(m),false,false);
  return max2f(__uint_as_float(rr[0]),__uint_as_float(rr[1]));
}
__device__ __forceinline__ void pv(f32x16*o,int vb,bf16x8 pa0,bf16x8 pa1,bf16x8 pa2,bf16x8 pa3){
  #pragma unroll
  for(int d0=0;d0<2;++d0){s16x4 lo[4],hi[4];
    #pragma unroll
    for(int ks=0;ks<4;++ks){
      asm volatile("ds_read_b64_tr_b16 %0,%1 offset:%c2":"=&v"(lo[ks]):"v"(vb),"i"(d0*4096+ks*1024):"memory");
      asm volatile("ds_read_b64_tr_b16 %0,%1 offset:%c2":"=&v"(hi[ks]):"v"(vb),"i"(d0*4096+ks*1024+512):"memory");}
    asm volatile("s_waitcnt lgkmcnt(0)":::"memory");SBAR();
    #define PK(k) (bf16x8){lo[k][0],lo[k][1],lo[k][2],lo[k][3],hi[k][0],hi[k][1],hi[k][2],hi[k][3]}
    o[d0]=__builtin_amdgcn_mfma_f32_32x32x16_bf16(pa0,PK(0),o[d0],0,0,0);
    o[d0]=__builtin_amdgcn_mfma_f32_32x32x16_bf16(pa1,PK(1),o[d0],0,0,0);
    o[d0]=__builtin_amdgcn_mfma_f32_32x32x16_bf16(pa2,PK(2),o[d0],0,0,0);
    o[d0]=__builtin_amdgcn_mfma_f32_32x32x16_bf16(pa3,PK(3),o[d0],0,0,0);
    #undef PK
  }
}

#ifndef ATTN_STORE16
#define ATTN_STORE16(p,v) (*(u32x4*)(p)=(v))
#endif
template<int THRL,int NTT=SEQ/KVBLK> __device__ __forceinline__ void attn_unit(int b,int h,int qb,const bf16*Q,const bf16*__restrict__ K,const bf16*__restrict__ V,bf16*O,char*shm,const int wave_id){
  const int tid_=wave_id*64+mk_lane();
  const int tid=tid_,lane=tid&63,r32=lane&31,hi=lane>>5; const int wid=__builtin_amdgcn_readfirstlane(tid>>6);
  const long rowbase=(long)b*SEQ; const int q0=qb*QB;
  const bf16*Qw=Q+(rowbase+q0+wid*QBLK)*PQ+h*D;
  const bf16*Kh=K+rowbase*PKV+(h>>2)*D,*Vh=V+rowbase*PKV+(h>>2)*D;
  const unsigned lds0=(unsigned)(uintptr_t)shm;
  float*wsf=(float*)(shm+LDS_WS)+wid*64;
  const bf16*ksrc=Kh+(long)lane*PKV+wid*8;
  const bf16*vsrc=Vh+(long)(16*(wid&3)+(lane>>2))*PKV+(wid>>2)*32+(lane&3)*8;
  const unsigned kdst=lds0+LDS_K+wid*1024, vdst=lds0+LDS_V+wid*1024;
  #define DMA_K(t,slot) glds16(ksrc+(long)(t)*KVBLK*PKV,(unsigned)__builtin_amdgcn_readfirstlane(kdst+(slot)))
  #define DMA_V(t,slot) glds16(vsrc+(long)(t)*KVBLK*PKV,(unsigned)__builtin_amdgcn_readfirstlane(vdst+(slot)))
  const int vb0=(int)(lds0+LDS_V)+((lane>>4)&1)*32+(lane&3)*8+(4*hi+((lane&15)>>2))*64;
  const char*Kbase=shm+LDS_K; bf16x8 kf[8];
  const lds_cptr shm3=(lds_cptr)shm; const lds_cptr kp0=shm3+LDS_K+hi*1024+r32*16; const lds_cptr vp0=shm3+LDS_V+((lane>>4)&1)*32+(lane&3)*8+(4*hi+((lane&15)>>2))*64;
  constexpr int NT=NTT;
  DMA_K(0,0);DMA_V(0,0);DMA_K(1,SLOTB);
  bf16x8 qr[4];
  #pragma unroll
  for(int d0=0;d0<4;++d0)qr[d0]=*reinterpret_cast<const bf16x8*>(&Qw[(long)r32*PQ+d0*16+hi*8]);
  float mhat=0.f,l_reg=0.f;float zf_=0.f;asm volatile("":"+v"(zf_));f32x16 o[2];
  #pragma unroll
  for(int r=0;r<16;++r){o[0][r]=zf_;o[1][r]=zf_;}
  f32x16 negm;
  #pragma unroll
  for(int r=0;r<16;++r)negm[r]=zf_;
  asm volatile("":"+v"(negm));
  const int qrel=wid*QBLK+r32;
  #define CMASK(P0,P1,t) do{}while(0)
  bool resc=false;
  #define START(P0,P1) do{ const float rm=rowmax(P0,P1); resc=false; \
    { const float dl=rm; mhat=fadd_s(mhat,dl); \
      _Pragma("unroll") for(int r=0;r<16;++r){P0[r]=fsub_s(P0[r],dl);P1[r]=fsub_s(P1[r],dl);} \
      _Pragma("unroll") for(int r=0;r<16;++r)negm[r]=-mhat; asm volatile("":"+v"(negm)); } \
    _Pragma("unroll") for(int r=0;r<16;++r)P0[r]=__builtin_amdgcn_exp2f(P0[r]); }while(0)
  #define RESC() do{ if(resc){ asm volatile("s_waitcnt lgkmcnt(0)":::"memory"); \
      _Pragma("unroll") for(int d_=0;d_<2;++d_) _Pragma("unroll") for(int r=0;r<16;++r)o[d_][r]*=wsf[crow(r,hi)]; } }while(0)
  f32x16 pA0,pA1,pB0,pB1;
  int sl_prev=0,sl_cur=0,sl_next=SLOTB;
  #define ROT() do{sl_prev=sl_cur;sl_cur=sl_next;sl_next=(sl_next==(NSLOT-1)*SLOTB)?0:sl_next+SLOTB;}while(0)
  DMA_K(2,2*SLOTB);
  WAIT_BAR(3);
  qkt(pA0,pA1,Kbase,qr,negm,r32,hi);asm volatile("s_nop 15\n\ts_nop 7":"+v"(pA0),"+v"(pA1));CMASK(pA0,pA1,0);
  START(pA0,pA1);
  _Pragma("unroll") for(int r=0;r<16;++r)pA1[r]=__builtin_amdgcn_exp2f(pA1[r]);
  WAIT_BAR(0);
  DMA_K(3,0);DMA_V(1,SLOTB);
  ROT();
  kload8(kf,kp0+sl_cur);
  WAIT_BAR(2);
  s16x4 vlo[8],vhi[8]; u32x4 pw0,pw1,pw2,pw3;
  #define PKW(P,B) cvtpk_s(P[B],P[B+1])
  #define PAF(k) __builtin_bit_cast(bf16x8,pw##k)
  #define VFR(i) (bf16x8){vlo[i][0],vlo[i][1],vlo[i][2],vlo[i][3],vhi[i][0],vhi[i][1],vhi[i][2],vhi[i][3]}
  #define PIN(x) asm volatile("":"+v"(x))
  #define MX3(a,b,c) __builtin_fmaxf(__builtin_fmaxf((a),(b)),(c))
  #define GAPA(MF,A0,A1,A2,A3,W0,W1,PW) do{ MF; sacc+=A0; sacc+=A1; sacc+=A2; sacc+=A3; PIN(sacc); W0; W1; PIN(PW); SBAR(); }while(0)
  #define EX(v) __builtin_amdgcn_exp2f(v)
  #define GAPB(MF,X,B) do{ MF; X[B]=EX(X[B]); X[B+1]=EX(X[B+1]); X[B+2]=EX(X[B+2]); X[B+3]=EX(X[B+3]); PIN(X); SBAR(); }while(0)
  #define VRD(i) do{ vlo[i]=vtr(vp_+(((i)>>2)*4096+((i)&3)*1024)); vhi[i]=vtr(vp_+(((i)>>2)*4096+((i)&3)*1024+512)); }while(0)
  #define KRD(G,j) do{ if(G){ kload2(kf,kp0+sl_next,j); SBAR(); } }while(0)
  #define STEP(C0,C1,P0,P1,t,GK,GV,GL) do{ SBAR(); \
    const lds_cptr vp_=vp0+sl_prev; \
    VRD(0); SBAR(); float sacc=(P0[0]+P0[1]); \
    GAPA(C0=__builtin_amdgcn_mfma_f32_32x32x16_bf16(kf[0],qr[0],negm,0,0,0), P0[2],P0[3],P0[4],P0[5],     pw0[0]=PKW(P0,0), pw0[1]=PKW(P0,2), pw0); \
    VRD(4); SBAR(); GAPA(C1=__builtin_amdgcn_mfma_f32_32x32x16_bf16(kf[1],qr[0],negm,0,0,0), P0[6],P0[7],P0[8],P0[9],     pw0[2]=PKW(P0,4), pw0[3]=PKW(P0,6), pw0); \
    VRD(1); SBAR(); GAPA(C0=__builtin_amdgcn_mfma_f32_32x32x16_bf16(kf[2],qr[1],C0,0,0,0),   P0[10],P0[11],P0[12],P0[13], pw1[0]=PKW(P0,8), pw1[1]=PKW(P0,10), pw1); \
    VRD(5); SBAR(); GAPA(C1=__builtin_amdgcn_mfma_f32_32x32x16_bf16(kf[3],qr[1],C1,0,0,0),   P0[14],P0[15],P1[0],P1[1],   pw1[2]=PKW(P0,12),pw1[3]=PKW(P0,14), pw1); \
    VRD(2); SBAR(); GAPA(C0=__builtin_amdgcn_mfma_f32_32x32x16_bf16(kf[4],qr[2],C0,0,0,0),   P1[2],P1[3],P1[4],P1[5],     pw2[0]=PKW(P1,0), pw2[1]=PKW(P1,2), pw2); \
    VRD(6); SBAR(); GAPA(C1=__builtin_amdgcn_mfma_f32_32x32x16_bf16(kf[5],qr[2],C1,0,0,0),   P1[6],P1[7],P1[8],P1[9],     pw2[2]=PKW(P1,4), pw2[3]=PKW(P1,6), pw2); \
    VRD(3); SBAR(); GAPA(C0=__builtin_amdgcn_mfma_f32_32x32x16_bf16(kf[6],qr[3],C0,0,0,0),   P1[10],P1[11],P1[12],P1[13], pw3[0]=PKW(P1,8), pw3[1]=PKW(P1,10), pw3); \
    VRD(7); SBAR(); GAPA(C1=__builtin_amdgcn_mfma_f32_32x32x16_bf16(kf[7],qr[3],C1,0,0,0),   P1[14],P1[15],0.f,0.f,       pw3[2]=PKW(P1,12),pw3[3]=PKW(P1,14), pw3); \
    l_reg+=sacc; \
    if(GK){DMA_K((t)+3,sl_cur);} if(GV){DMA_V((t)+1,sl_next);} \
    CMASK(C0,C1,t); \
    { float a=MX3(C0[0],C0[1],C1[0]),b=MX3(C0[2],C0[3],C1[1]); a=MX3(a,C1[2],C1[3]); \
      _Pragma("unroll") for(int r=4;r<16;r+=4){a=MX3(a,C0[r],C0[r+1]);b=MX3(b,C0[r+2],C0[r+3]);a=MX3(a,C1[r],C1[r+1]);b=MX3(b,C1[r+2],C1[r+3]);} \
      float rm=__builtin_fmaxf(a,b); { auto rr=__builtin_amdgcn_permlane32_swap(__float_as_uint(rm),__float_as_uint(rm),false,false); rm=__builtin_fmaxf(__uint_as_float(rr[0]),__uint_as_float(rr[1])); } \
      resc=false; \
      if(__builtin_expect(__any(rm>(float)THRL),0)){ const float dl=__builtin_fmaxf(rm,0.f); mhat+=dl; \
        _Pragma("unroll") for(int r=0;r<16;++r){C0[r]-=dl;C1[r]-=dl;} \
        _Pragma("unroll") for(int r=0;r<16;++r)negm[r]=-mhat; asm volatile("":"+v"(negm)); \
        const float f=__builtin_amdgcn_exp2f(-dl); l_reg*=f; if(hi==0)wsf[r32]=f; resc=true; } } \
    SBAR(); \
    GAPB(o[0]=__builtin_amdgcn_mfma_f32_32x32x16_bf16(PAF(0),VFR(0),o[0],0,0,0), C0,0); \
    GAPB(o[1]=__builtin_amdgcn_mfma_f32_32x32x16_bf16(PAF(0),VFR(4),o[1],0,0,0), C0,4); \
    KRD(GL,0); GAPB(o[0]=__builtin_amdgcn_mfma_f32_32x32x16_bf16(PAF(1),VFR(1),o[0],0,0,0), C0,8); \
    KRD(GL,1); GAPB(o[1]=__builtin_amdgcn_mfma_f32_32x32x16_bf16(PAF(1),VFR(5),o[1],0,0,0), C0,12); \
    KRD(GL,2); GAPB(o[0]=__builtin_amdgcn_mfma_f32_32x32x16_bf16(PAF(2),VFR(2),o[0],0,0,0), C1,0); \
    KRD(GL,3); GAPB(o[1]=__builtin_amdgcn_mfma_f32_32x32x16_bf16(PAF(2),VFR(6),o[1],0,0,0), C1,4); \
    GAPB(o[0]=__builtin_amdgcn_mfma_f32_32x32x16_bf16(PAF(3),VFR(3),o[0],0,0,0), C1,8); \
    GAPB(o[1]=__builtin_amdgcn_mfma_f32_32x32x16_bf16(PAF(3),VFR(7),o[1],0,0,0), C1,12); \
    }while(0)
  int t=1;
  #undef CMASK
  #define CMASK(P0,P1,t) do{}while(0)
#ifdef LOOP_ALIGN
  asm volatile(".p2align " LOOP_ALIGN_STR);
#endif
  for(;t+5<NT;t+=2){
    STEP(pB0,pB1,pA0,pA1,t,true,true,true);     WAIT_BAR(2); RESC(); ROT();
    STEP(pA0,pA1,pB0,pB1,t+1,true,true,true);   WAIT_BAR(2); RESC(); ROT();
  }
  #undef CMASK
  #define CMASK(P0,P1,t) do{}while(0)
  #define ENDW(tt) do{ if((tt)+3<NT){WAIT_BAR(2);} else if((tt)+2<NT){WAIT_BAR(1);} else {WAIT_BAR(0);} }while(0)
  for(;t+1<NT;t+=2){
    STEP(pB0,pB1,pA0,pA1,t,(t+3<NT),(t+1<NT),(t+1<NT));       ENDW(t);   RESC(); ROT();
    STEP(pA0,pA1,pB0,pB1,t+1,(t+4<NT),(t+2<NT),(t+2<NT));     ENDW(t+1); RESC(); ROT();
  }
  STEP(pB0,pB1,pA0,pA1,NT-1,false,false,false); RESC();
  { float sacc=pB0[0]+pB0[1]; _Pragma("unroll") for(int r=2;r<16;++r)sacc+=pB0[r]; _Pragma("unroll") for(int r=0;r<16;++r)sacc+=pB1[r]; l_reg+=sacc;
    pw0=(u32x4){PKW(pB0,0),PKW(pB0,2),PKW(pB0,4),PKW(pB0,6)};pw1=(u32x4){PKW(pB0,8),PKW(pB0,10),PKW(pB0,12),PKW(pB0,14)};pw2=(u32x4){PKW(pB1,0),PKW(pB1,2),PKW(pB1,4),PKW(pB1,6)};pw3=(u32x4){PKW(pB1,8),PKW(pB1,10),PKW(pB1,12),PKW(pB1,14)};
    SBAR(); pv(o,vb0+sl_cur,PAF(0),PAF(1),PAF(2),PAF(3)); }
  #undef PKW
  #undef PAF
  #undef VFR
  #undef PIN
  #undef MX3
  #undef GAPA
  #undef GAPB
  #undef EX
  #undef VRD
  #undef KRD
  #undef STEP
  #undef ENDW
  {auto rr=__builtin_amdgcn_permlane32_swap(__float_as_uint(l_reg),__float_as_uint(l_reg),false,false);l_reg=__uint_as_float(rr[0])+__uint_as_float(rr[1]);}
  if(hi==0)wsf[32+r32]=l_reg;asm volatile("s_waitcnt lgkmcnt(0)":::"memory");
  float rli[16];
  #pragma unroll
  for(int r=0;r<16;++r)rli[r]=__builtin_amdgcn_rcpf(wsf[32+crow(r,hi)]);
  bf16*Ow=O+(rowbase+q0+wid*QBLK)*PO+h*D;
  { bf16*stg=(bf16*)(shm+LDS_OST)+wid*2048;
    #pragma unroll
    for(int r=0;r<16;++r){const int orow=crow(r,hi);
      #pragma unroll
      for(int d0=0;d0<2;++d0)stg[orow*64+d0*32+r32]=__float2bfloat16(o[d0][r]*rli[r]);}
    asm volatile("s_waitcnt lgkmcnt(0)":::"memory");
    #pragma unroll
    for(int i=0;i<4;++i){const int row=i*8+(lane>>3),ch=lane&7; const u32x4 v=*(const u32x4*)(stg+row*64+ch*8); ATTN_STORE16(Ow+(long)row*PO+ch*8,v);} }
  asm volatile("s_waitcnt lgkmcnt(0)\n\ts_barrier":::"memory");
  #undef DMA_K
  #undef DMA_V
  #undef CMASK
  #undef START
  #undef RESC
  #undef ROT
}
constexpr int ATTN_LDS_BYTES=LDS_BYTES;
struct AttnTensors { const bf16* Q; const bf16* K; const bf16* V; bf16* O; };
#undef SBAR
#undef WAIT_BAR
}
namespace ssd {
typedef float f32x16 __attribute__((ext_vector_type(16)));
typedef short v4i16_t __attribute__((ext_vector_type(4)));
typedef unsigned u32x2 __attribute__((ext_vector_type(2)));
typedef LAS unsigned char* lptr;
constexpr int XBLK = 8192 + 64;
constexpr int KCH = 2048 + 16;
constexpr int L_X = 0;
constexpr int L_B = L_X + 8 * XBLK;
constexpr int L_C = L_B + 16 * KCH;
constexpr int L_SC = L_C + 16 * KCH;
constexpr int L_W = L_SC + 8192;
constexpr int L_END = L_W + 4096;
static_assert(4 * XBLK == 16 * KCH, "B region holds either image");
__device__ __forceinline__ int crow(int r, int hi) { return (r & 3) + 8 * (r >> 2) + 4 * hi; }
__device__ __forceinline__ v4i16_t vtr(lptr p) { return __builtin_amdgcn_ds_read_tr16_b64_v4i16((LAS v4i16_t*)p); }
typedef float f32x2_t __attribute__((ext_vector_type(2))); typedef __bf16 bf16x2_t __attribute__((ext_vector_type(2)));
__device__ __forceinline__ unsigned cvtpk(float lo, float hi) { const f32x2_t v = {lo, hi}; return __builtin_bit_cast(unsigned, __builtin_convertvector(v, bf16x2_t)); }
__device__ __forceinline__ float bfl(unsigned v) { return __uint_as_float(v << 16); }
__device__ __forceinline__ float bfh(unsigned v) { return __uint_as_float(v & 0xffff0000u); }
__device__ __forceinline__ f32x16 zero16() { float z = 0.f; asm volatile("" : "+v"(z)); f32x16 r;
#pragma unroll
    for (int i = 0; i < 16; ++i) r[i] = z;
    return r; }
__device__ __forceinline__ float silu(float v) { return v * __builtin_amdgcn_rcpf(1.0f + __builtin_amdgcn_exp2f(-1.4426950408889634f * v)); }

template <bool S3>
__device__ __forceinline__ void conv_stage(lptr lds, const bf16* __restrict__ XR, const float* __restrict__ cw, const float* __restrict__ cb, int b, int c, int g, int tid) {
    const int tq = tid >> 7, cq = tid & 127;
    if (S3 || cq < 96) {
        int col; unsigned dst; int rs;
        if (cq < 64) { col = g * 256 + 4 * cq; dst = L_X + (cq >> 3) * XBLK + (cq & 7) * 8; rs = 64; }
        else { const int q = (cq - 64) & 31; col = (cq < 96 ? 512 : 768) + g * 128 + 4 * q;
            if (S3) { dst = (cq < 96 ? L_B : L_C) + (q >> 1) * KCH + (q & 1) * 8; rs = 16; } else { dst = L_B + (q >> 3) * XBLK + (q & 7) * 8; rs = 64; } }
        dst += (unsigned)(tq * 32 * rs);
        f32x4 w[5];
#pragma unroll
        for (int j = 0; j < 5; ++j) w[j] = *(const f32x4*)(cw + j * NCONV + col);
        const f32x4 bias = *(const f32x4*)(cb + col);
        const int t0 = c * 128 + tq * 32 - 2;
        const bf16* src = XR + ((size_t)b * SEQ) * NCONV + col;
#ifndef OPT_CONV1
#define OPT_CONV1 0
#endif
#if OPT_CONV1
        u32x2 in[36];
#pragma unroll
        for (int i = 0; i < 36; ++i) { const int tt = t0 + i; const bool ok = tt >= 0 && tt < SEQ; const int tc = tt < 0 ? 0 : (tt >= SEQ ? SEQ - 1 : tt);
            const u32x2 v = *(const u32x2*)(src + (size_t)tc * NCONV); in[i].x = ok ? v.x : 0u; in[i].y = ok ? v.y : 0u; }
#pragma unroll
        for (int o = 0; o < 32; ++o) {
            f32x4 a = bias;
#pragma unroll
            for (int j = 0; j < 5; ++j) { const u32x2 v = in[o + j]; a += w[j] * (f32x4){bfl(v.x), bfh(v.x), bfl(v.y), bfh(v.y)}; }
            u32x2 pk; pk.x = cvtpk(silu(a[0]), silu(a[1])); pk.y = cvtpk(silu(a[2]), silu(a[3]));
            *(LAS u32x2*)(lds + dst + (unsigned)(o * rs)) = pk;
        }
#else
#pragma unroll
        for (int hf = 0; hf < 2; ++hf) {
            u32x2 in[20];
#pragma unroll
            for (int i = 0; i < 20; ++i) { const int tt = t0 + hf * 16 + i; const int tc = tt < 0 ? 0 : (tt >= SEQ ? SEQ - 1 : tt);
                in[i] = *(const u32x2*)(src + (size_t)tc * NCONV); }
            __builtin_amdgcn_sched_barrier(0);
#pragma unroll
            for (int i = 0; i < 20; ++i) { const int tt = t0 + hf * 16 + i; const bool ok = tt >= 0 && tt < SEQ; in[i].x = ok ? in[i].x : 0u; in[i].y = ok ? in[i].y : 0u; }
#pragma unroll
            for (int o = 0; o < 16; ++o) {
                f32x4 a = bias;
#pragma unroll
                for (int j = 0; j < 5; ++j) { const u32x2 v = in[o + j]; a = fma4(w[j], (f32x4){bfl(v.x), bfh(v.x), bfl(v.y), bfh(v.y)}, a); }
                u32x2 pk; pk.x = cvtpk(silu(a[0]), silu(a[1])); pk.y = cvtpk(silu(a[2]), silu(a[3]));
                *(LAS u32x2*)(lds + dst + (unsigned)((hf * 16 + o) * rs)) = pk;
            }
        }
#endif
    }
}
template <bool S1>
__device__ __forceinline__ void scalar_stage(lptr lds, const float* __restrict__ DT, const float* __restrict__ dt_bias, const float* __restrict__ a_log, float* __restrict__ CD, int b, int c, int g, int wid, int lane) {
    const int hd = wid >> 1, dir = wid & 1, hg = 4 * g + hd;
    const float bias = dt_bias[dir * 8 + hg], av = -__expf(a_log[dir * 8 + hg]);
    const size_t m0 = (size_t)b * SEQ + c * 128 + 2 * lane;
    const float v0 = DT[m0 * 16 + dir * 8 + hg] + bias, v1 = DT[(m0 + 1) * 16 + dir * 8 + hg] + bias;
    const float d0 = fmaxf(v0, 0.f) + log1pf(__expf(-fabsf(v0))), d1 = fmaxf(v1, 0.f) + log1pf(__expf(-fabsf(v1)));
    const float l0 = d0 * av, l1 = d1 * av, pair = l0 + l1;
    float incl = pair;
#pragma unroll
    for (int o = 1; o < 64; o <<= 1) { const float t = __shfl_up(incl, o); if (lane >= o) incl += t; }
    const float total = __shfl(incl, 63);
    float a0, a1;
    if (dir == 0) { a0 = (incl - pair) + l0; a1 = a0 + l1; } else { a1 = (total - incl) + l1; a0 = a1 + l0; }
    LAS float* sc = (LAS float*)(lds + L_SC) + (hd * 128 + 2 * lane) * 4;
    sc[dir] = a0; sc[2 + dir] = d0; sc[4 + dir] = a1; sc[6 + dir] = d1;
    if (S1) {
        LAS float* wv = (LAS float*)(lds + L_W) + (hd * 2 + dir) * 128 + 2 * lane;
        wv[0] = d0 * __expf(total - a0); wv[1] = d1 * __expf(total - a1);
        if (lane == 0) CD[((b * 32 + c) * 2 + dir) * 8 + hg] = __expf(total);
    }
}

__device__ __forceinline__ void s1_unit(lptr lds, const bf16* __restrict__ XR, const float* __restrict__ DT, const float* cw, const float* cb, const float* dt_bias, const float* a_log,
                                        bf16* __restrict__ ST, float* __restrict__ CD, int b, int c, int g, const int wave_id) {
    const int tid_ = wave_id * 64 + mk_lane();
    const int tid = tid_, lane = tid & 63, wid = __builtin_amdgcn_readfirstlane(tid >> 6), r = lane & 31, h = lane >> 5;
#ifndef OPT_C
#define OPT_C 0
#endif
    if (OPT_C) scalar_stage<true>(lds, DT, dt_bias, a_log, CD, b, c, g, wid, lane);
    conv_stage<false>(lds, XR, cw, cb, b, c, g, tid);
    if (!OPT_C) scalar_stage<true>(lds, DT, dt_bias, a_log, CD, b, c, g, wid, lane);
    __syncthreads();
    const int hd = wid >> 1, dir = wid & 1, hg = 4 * g + hd;
    const unsigned trb = (unsigned)(((lane >> 4) & 1) * 32 + (lane & 3) * 8 + (4 * h + ((lane & 15) >> 2)) * 64);
    f32x16 acc[2][4];
#pragma unroll
    for (int pt = 0; pt < 2; ++pt)
#pragma unroll
        for (int nt = 0; nt < 4; ++nt) acc[pt][nt] = zero16();
#pragma unroll 2
    for (int k = 0; k < 8; ++k) {
        const LAS f32x4* wp = (const LAS f32x4*)(lds + L_W + ((hd * 2 + dir) * 128 + 16 * k + 4 * h) * 4);
        const f32x4 w0 = wp[0], w1 = wp[2];
        bf16x8 af[2], bfr[4];
#pragma unroll
        for (int pt = 0; pt < 2; ++pt) { const lptr p = lds + L_X + (hd * 2 + pt) * XBLK + trb + k * 1024; const v4i16_t lo = vtr(p), hi = vtr(p + 512);
            unsigned o[4];
            o[0] = cvtpk(bfl((unsigned short)lo[0]) * w0[0], bfl((unsigned short)lo[1]) * w0[1]); o[1] = cvtpk(bfl((unsigned short)lo[2]) * w0[2], bfl((unsigned short)lo[3]) * w0[3]);
            o[2] = cvtpk(bfl((unsigned short)hi[0]) * w1[0], bfl((unsigned short)hi[1]) * w1[1]); o[3] = cvtpk(bfl((unsigned short)hi[2]) * w1[2], bfl((unsigned short)hi[3]) * w1[3]);
            af[pt] = __builtin_bit_cast(bf16x8, (v4u){o[0], o[1], o[2], o[3]}); }
#pragma unroll
        for (int nt = 0; nt < 4; ++nt) { const lptr p = lds + L_B + nt * XBLK + trb + k * 1024; const v4i16_t lo = vtr(p), hi = vtr(p + 512);
            bfr[nt] = (bf16x8){lo[0], lo[1], lo[2], lo[3], hi[0], hi[1], hi[2], hi[3]}; }
#pragma unroll
        for (int pt = 0; pt < 2; ++pt)
#pragma unroll
            for (int nt = 0; nt < 4; ++nt) acc[pt][nt] = __builtin_amdgcn_mfma_f32_32x32x16_bf16(bfr[nt], af[pt], acc[pt][nt], 0, 0, 0);
    }
    bf16* dp = ST + (size_t)(((b * 32 + c) * 2 + dir) * 8 + hg) * 8192 + r * 128 + 4 * h;
#pragma unroll
    for (int pt = 0; pt < 2; ++pt)
#pragma unroll
        for (int nt = 0; nt < 4; ++nt)
#pragma unroll
            for (int q = 0; q < 4; ++q) { u32x2 o; o.x = cvtpk(acc[pt][nt][4 * q], acc[pt][nt][4 * q + 1]); o.y = cvtpk(acc[pt][nt][4 * q + 2], acc[pt][nt][4 * q + 3]);
                *(u32x2*)(dp + pt * 32 * 128 + 32 * nt + 8 * q) = o; }
    __syncthreads();
}

__device__ __forceinline__ void s2_scan(bf16* __restrict__ ST, const float* __restrict__ CD, int first, int stride) {
    for (int gid = first; gid < BATCH * 2 * 8 * 64 * 16; gid += stride) {
#ifndef SSD_SPLIT
#define SSD_SPLIT 1
#endif
#if SSD_SPLIT
        const int p = gid & 63, n8 = (gid >> 6) & 15, hg = (gid >> 10) & 7, dir = (gid >> 13) & 1, b = gid >> 14; const int eoff = (n8 * 64 + p) * 8;
#else
        const int n8 = gid & 15, p = (gid >> 4) & 63, hg = (gid >> 10) & 7, dir = (gid >> 13) & 1, b = gid >> 14; const int eoff = p * 128 + n8 * 8;
#endif
        const int c0 = dir ? 31 : 0; const long cstep = dir ? -(long)(2 * 8 * 8192) : (long)(2 * 8 * 8192);
        bf16* sp = ST + (size_t)(((b * 32 + c0) * 2 + dir) * 8 + hg) * 8192 + eoff;
        const float* cp = CD + ((b * 32 + c0) * 2 + dir) * 8 + hg; const int cdstep = dir ? -16 : 16;
        float run[8]; float zf = 0.f; asm volatile("" : "+v"(zf));
#pragma unroll
        for (int k = 0; k < 8; ++k) run[k] = zf;
#ifndef S2_BATCH
#define S2_BATCH 8
#endif
#pragma unroll 1
        for (int cb = 0; cb < 32 / S2_BATCH; ++cb) {
            v4u v[S2_BATCH]; float cd[S2_BATCH];
#pragma unroll
            for (int i = 0; i < S2_BATCH; ++i) { v[i] = *(const v4u*)(sp + i * cstep); cd[i] = cp[i * cdstep]; }
            __builtin_amdgcn_sched_barrier(0);
#pragma unroll
            for (int i = 0; i < S2_BATCH; ++i) {
                v4u o; o.x = cvtpk(run[0], run[1]); o.y = cvtpk(run[2], run[3]); o.z = cvtpk(run[4], run[5]); o.w = cvtpk(run[6], run[7]);
                *(v4u*)(sp + i * cstep) = o;
                run[0] = run[0] * cd[i] + bfl(v[i].x); run[1] = run[1] * cd[i] + bfh(v[i].x); run[2] = run[2] * cd[i] + bfl(v[i].y); run[3] = run[3] * cd[i] + bfh(v[i].y);
                run[4] = run[4] * cd[i] + bfl(v[i].z); run[5] = run[5] * cd[i] + bfh(v[i].z); run[6] = run[6] * cd[i] + bfl(v[i].w); run[7] = run[7] * cd[i] + bfh(v[i].w); }
            sp += S2_BATCH * cstep; cp += S2_BATCH * cdstep;
        }
    }
}

__device__ __forceinline__ void s3_unit(lptr lds, const bf16* __restrict__ XR, const float* __restrict__ DT, const bf16* __restrict__ Z, const float* cw, const float* cb, const float* dt_bias, const float* a_log,
                                        const float* __restrict__ dsk, const float* __restrict__ nw, const bf16* __restrict__ ST, bf16* __restrict__ MIX, int b, int c, int g, const int wave_id) {
    const int tid_ = wave_id * 64 + mk_lane();
    const int tid = tid_, lane = tid & 63, wid = __builtin_amdgcn_readfirstlane(tid >> 6), r = lane & 31, h = lane >> 5;
#ifndef REP_S3CONV
#define REP_S3CONV 1
#endif
#ifndef REP_S3OFF
#define REP_S3OFF 1
#endif
#ifndef REP_S3DIAG
#define REP_S3DIAG 1
#endif
    if (OPT_C) scalar_stage<false>(lds, DT, dt_bias, a_log, nullptr, b, c, g, wid, lane);
    for (int rep_ = 0; rep_ < REP_S3CONV; ++rep_) { conv_stage<true>(lds, XR, cw, cb, b, c, g, tid); if (REP_S3CONV > 1) { asm volatile("s_waitcnt vmcnt(0) lgkmcnt(0)" ::: "memory"); __syncthreads(); } }
    if (!OPT_C) scalar_stage<false>(lds, DT, dt_bias, a_log, nullptr, b, c, g, wid, lane);
    __syncthreads();
    const int lb = wid >> 1, hp = wid & 1, l = 32 * lb + r;
    const unsigned trb = (unsigned)(((lane >> 4) & 1) * 32 + (lane & 3) * 8 + (4 * h + ((lane & 15) >> 2)) * 64);
    const lptr cfp = lds + L_C + h * KCH + l * 16;
    const size_t tok = (size_t)b * SEQ + c * 128 + l;
    float ssum = 0.f;
    unsigned yk[2][2][8];
#pragma unroll
    for (int h2 = 0; h2 < 2; ++h2) {
        const int hd = 2 * hp + h2, hg = 4 * g + hd;
        const f32x4 scl = *(const LAS f32x4*)(lds + L_SC + (hd * 128 + l) * 16);
        f32x16 y[2]; y[0] = zero16(); y[1] = zero16();
        const float dskip = dsk[hg];
#ifndef OPT_FLIP
#define OPT_FLIP 0
#endif
        if (OPT_FLIP && ((wid >> 2) & 1)) {
        int lh = l; asm volatile("" : "+v"(lh));
        for (int rep_ = 0; rep_ < REP_S3DIAG; ++rep_)
#pragma unroll
        for (int st = 0; st < 4; ++st) {
            float kd = 1.f; if (REP_S3DIAG > 1) { kd = rep_ ? 0.f : 1.f; asm volatile("" : "+v"(kd)); }
            f32x16 gt = zero16();
#pragma unroll
            for (int ks = 0; ks < 8; ++ks) { const bf16x8 a = *(const LAS bf16x8*)(lds + L_B + (2 * ks + h) * KCH + (32 * st + r) * 16); const bf16x8 cfk = *(const LAS bf16x8*)(cfp + ks * 2 * KCH); gt = __builtin_amdgcn_mfma_f32_32x32x16_bf16(a, cfk, gt, 0, 0, 0); }
            unsigned o[8];
#ifndef OPT_B
#define OPT_B 0
#endif
            if (!OPT_B || st == lb) {
#pragma unroll
                for (int rp = 0; rp < 8; ++rp) { float pw[2];
#pragma unroll
                    for (int e2 = 0; e2 < 2; ++e2) { const int rg = 2 * rp + e2, s = 32 * st + crow(rg, h); const f32x4 scs = *(const LAS f32x4*)(lds + L_SC + (hd * 128 + s) * 16);
                        const int d = s - lh; const bool lt = d < 0;
                        const float arg = lt ? scl[0] - scs[0] : scl[1] - scs[1]; const float coef = lt ? scs[2] : scs[3];
                        float v = gt[rg] * coef * __expf(arg); if (d == 0) v = gt[rg] * (scs[2] + scs[3]) + dskip; pw[e2] = (REP_S3DIAG > 1) ? v * kd : v; }
                    o[rp] = cvtpk(pw[0], pw[1]); }
            } else {
                const bool fw = st < lb; const int ci = fw ? 0 : 1;
                const float ref = *(const LAS float*)(lds + L_SC + (hd * 128 + (fw ? 32 * lb - 1 : 32 * lb + 32)) * 16 + 4 * ci);
                const float al = __expf(scl[ci] - ref) * ((REP_S3DIAG > 1) ? kd : 1.0f);
#pragma unroll
                for (int rp = 0; rp < 8; ++rp) { float pw[2];
#pragma unroll
                    for (int e2 = 0; e2 < 2; ++e2) { const int rg = 2 * rp + e2, s = 32 * st + crow(rg, h); const f32x4 scs = *(const LAS f32x4*)(lds + L_SC + (hd * 128 + s) * 16);
                        pw[e2] = gt[rg] * (scs[2 + ci] * __expf(ref - scs[ci])) * al; }
                    o[rp] = cvtpk(pw[0], pw[1]); }
            }
            const bf16x8 pf0 = __builtin_bit_cast(bf16x8, (v4u){o[0], o[1], o[2], o[3]}), pf1 = __builtin_bit_cast(bf16x8, (v4u){o[4], o[5], o[6], o[7]});
#pragma unroll
            for (int ks2 = 0; ks2 < 2; ++ks2)
#pragma unroll
                for (int pt = 0; pt < 2; ++pt) { const lptr p = lds + L_X + (hd * 2 + pt) * XBLK + trb + (2 * st + ks2) * 1024; const v4i16_t lo = vtr(p), hi = vtr(p + 512);
                    const bf16x8 a = (bf16x8){lo[0], lo[1], lo[2], lo[3], hi[0], hi[1], hi[2], hi[3]};
                    y[pt] = __builtin_amdgcn_mfma_f32_32x32x16_bf16(a, ks2 ? pf1 : pf0, y[pt], 0, 0, 0); }
        }
        for (int rep_ = 0; rep_ < REP_S3OFF; ++rep_)
#pragma unroll
        for (int dir = 0; dir < 2; ++dir) {
            const bf16* sin = ST + (size_t)(((b * 32 + c) * 2 + dir) * 8 + hg) * 8192 + r * 128 + 8 * h;
            f32x16 yo[2]; yo[0] = zero16(); yo[1] = zero16();
#pragma unroll 4
            for (int ks = 0; ks < 8; ++ks) { const bf16x8 cfk = *(const LAS bf16x8*)(cfp + ks * 2 * KCH);
#pragma unroll
                for (int pt = 0; pt < 2; ++pt) { const bf16x8 a = *(const bf16x8*)(sin + pt * 32 * 128 + 16 * ks); yo[pt] = __builtin_amdgcn_mfma_f32_32x32x16_bf16(a, cfk, yo[pt], 0, 0, 0); } }
            float e = __expf(dir ? scl[1] : scl[0]); if (REP_S3OFF > 1) { float kz = rep_ ? 0.f : 1.f; asm volatile("" : "+v"(kz)); e *= kz; }
            y[0] += yo[0] * e; y[1] += yo[1] * e;
        }
        } else {
        for (int rep_ = 0; rep_ < REP_S3OFF; ++rep_)
#pragma unroll
        for (int dir = 0; dir < 2; ++dir) {
            const bf16* sin = ST + (size_t)(((b * 32 + c) * 2 + dir) * 8 + hg) * 8192 + r * 128 + 8 * h;
            f32x16 yo[2]; yo[0] = zero16(); yo[1] = zero16();
#pragma unroll 4
            for (int ks = 0; ks < 8; ++ks) { const bf16x8 cfk = *(const LAS bf16x8*)(cfp + ks * 2 * KCH);
#pragma unroll
                for (int pt = 0; pt < 2; ++pt) { const bf16x8 a = *(const bf16x8*)(sin + pt * 32 * 128 + 16 * ks); yo[pt] = __builtin_amdgcn_mfma_f32_32x32x16_bf16(a, cfk, yo[pt], 0, 0, 0); } }
            float e = __expf(dir ? scl[1] : scl[0]); if (REP_S3OFF > 1) { float kz = rep_ ? 0.f : 1.f; asm volatile("" : "+v"(kz)); e *= kz; }
            y[0] += yo[0] * e; y[1] += yo[1] * e;
        }
        int lh = l; asm volatile("" : "+v"(lh));
        for (int rep_ = 0; rep_ < REP_S3DIAG; ++rep_)
#pragma unroll
        for (int st = 0; st < 4; ++st) {
            float kd = 1.f; if (REP_S3DIAG > 1) { kd = rep_ ? 0.f : 1.f; asm volatile("" : "+v"(kd)); }
            f32x16 gt = zero16();
#pragma unroll
            for (int ks = 0; ks < 8; ++ks) { const bf16x8 a = *(const LAS bf16x8*)(lds + L_B + (2 * ks + h) * KCH + (32 * st + r) * 16); const bf16x8 cfk = *(const LAS bf16x8*)(cfp + ks * 2 * KCH); gt = __builtin_amdgcn_mfma_f32_32x32x16_bf16(a, cfk, gt, 0, 0, 0); }
            unsigned o[8];
#ifndef OPT_B
#define OPT_B 0
#endif
            if (!OPT_B || st == lb) {
#pragma unroll
                for (int rp = 0; rp < 8; ++rp) { float pw[2];
#pragma unroll
                    for (int e2 = 0; e2 < 2; ++e2) { const int rg = 2 * rp + e2, s = 32 * st + crow(rg, h); const f32x4 scs = *(const LAS f32x4*)(lds + L_SC + (hd * 128 + s) * 16);
                        const int d = s - lh; const bool lt = d < 0;
                        const float arg = lt ? scl[0] - scs[0] : scl[1] - scs[1]; const float coef = lt ? scs[2] : scs[3];
                        float v = gt[rg] * coef * __expf(arg); if (d == 0) v = gt[rg] * (scs[2] + scs[3]) + dskip; pw[e2] = (REP_S3DIAG > 1) ? v * kd : v; }
                    o[rp] = cvtpk(pw[0], pw[1]); }
            } else {
                const bool fw = st < lb; const int ci = fw ? 0 : 1;
                const float ref = *(const LAS float*)(lds + L_SC + (hd * 128 + (fw ? 32 * lb - 1 : 32 * lb + 32)) * 16 + 4 * ci);
                const float al = __expf(scl[ci] - ref) * ((REP_S3DIAG > 1) ? kd : 1.0f);
#pragma unroll
                for (int rp = 0; rp < 8; ++rp) { float pw[2];
#pragma unroll
                    for (int e2 = 0; e2 < 2; ++e2) { const int rg = 2 * rp + e2, s = 32 * st + crow(rg, h); const f32x4 scs = *(const LAS f32x4*)(lds + L_SC + (hd * 128 + s) * 16);
                        pw[e2] = gt[rg] * (scs[2 + ci] * __expf(ref - scs[ci])) * al; }
                    o[rp] = cvtpk(pw[0], pw[1]); }
            }
            const bf16x8 pf0 = __builtin_bit_cast(bf16x8, (v4u){o[0], o[1], o[2], o[3]}), pf1 = __builtin_bit_cast(bf16x8, (v4u){o[4], o[5], o[6], o[7]});
#pragma unroll
            for (int ks2 = 0; ks2 < 2; ++ks2)
#pragma unroll
                for (int pt = 0; pt < 2; ++pt) { const lptr p = lds + L_X + (hd * 2 + pt) * XBLK + trb + (2 * st + ks2) * 1024; const v4i16_t lo = vtr(p), hi = vtr(p + 512);
                    const bf16x8 a = (bf16x8){lo[0], lo[1], lo[2], lo[3], hi[0], hi[1], hi[2], hi[3]};
                    y[pt] = __builtin_amdgcn_mfma_f32_32x32x16_bf16(a, ks2 ? pf1 : pf0, y[pt], 0, 0, 0); }
        }
        }
        const bf16* zp = Z + tok * NSSD + g * 256 + hd * 64 + 4 * h;
#pragma unroll
        for (int pt = 0; pt < 2; ++pt)
#pragma unroll
            for (int q = 0; q < 4; ++q) { const u32x2 zv = *(const u32x2*)(zp + 32 * pt + 8 * q); const float z4[4] = {bfl(zv.x), bfh(zv.x), bfl(zv.y), bfh(zv.y)}; float yv[4];
#pragma unroll
                for (int i = 0; i < 4; ++i) { yv[i] = y[pt][4 * q + i] * silu(z4[i]); ssum += yv[i] * yv[i]; }
                yk[h2][pt][2 * q] = cvtpk(yv[0], yv[1]); yk[h2][pt][2 * q + 1] = cvtpk(yv[2], yv[3]); }
    }
    ssum += __shfl_xor(ssum, 32);
    LAS float* ssx = (LAS float*)(lds + L_W);
    if (h == 0) ssx[hp * 128 + l] = ssum;
    __syncthreads();
    const float rn = rsqrtf((ssx[l] + ssx[128 + l]) * (1.0f / 256.0f) + EPS);
#pragma unroll
    for (int h2 = 0; h2 < 2; ++h2) { const int hd = 2 * hp + h2; const int ch = g * 256 + hd * 64 + 4 * h; bf16* op = MIX + tok * D_MODEL + 512 + ch;
#pragma unroll
        for (int pt = 0; pt < 2; ++pt)
#pragma unroll
            for (int q = 0; q < 4; ++q) { const f32x4 wv = *(const f32x4*)(nw + ch + 32 * pt + 8 * q); const unsigned a0 = yk[h2][pt][2 * q], a1 = yk[h2][pt][2 * q + 1]; u32x2 o;
                o.x = cvtpk(bfl(a0) * rn * wv[0], bfh(a0) * rn * wv[1]); o.y = cvtpk(bfl(a1) * rn * wv[2], bfh(a1) * rn * wv[3]);
                *(u32x2*)(op + 32 * pt + 8 * q) = o; } }
    __syncthreads();
}
}
namespace ssd {
__device__ __forceinline__ void ssa_unit(lptr lds, const bf16* __restrict__ XR, const float* __restrict__ DT, const float* cw, const float* cb, const float* dt_bias, const float* a_log, const float* __restrict__ dsk,
                                         bf16* __restrict__ ST, float* __restrict__ CD, bf16* __restrict__ YD, bf16* __restrict__ CIMG, float* __restrict__ EX, int b, int c, int g, const int wave_id) {
    const int tid_ = wave_id * 64 + mk_lane();
    const int tid = tid_, lane = tid & 63, wid = __builtin_amdgcn_readfirstlane(tid >> 6), r = lane & 31, h = lane >> 5;
    conv_stage<true>(lds, XR, cw, cb, b, c, g, tid);
    scalar_stage<true>(lds, DT, dt_bias, a_log, CD, b, c, g, wid, lane);
    __syncthreads();
    const size_t tok0 = (size_t)b * SEQ + c * 128;
    { const size_t ubase = (size_t)((b * 32 + c) * 2 + g) * 16384;
#pragma unroll
      for (int j = 0; j < 4; ++j) { const int i = tid + 512 * j, ch8 = i >> 7, t = i & 127; *(v4u*)(CIMG + ubase + (size_t)i * 8) = *(const LAS v4u*)(lds + L_C + ch8 * KCH + t * 16); }
      const int hd = tid >> 7, tt = tid & 127; const f32x4 sc = *(const LAS f32x4*)(lds + L_SC + (hd * 128 + tt) * 16);
      EX[(tok0 + tt) * 16 + 4 * g + hd] = __expf(sc[0]); EX[(tok0 + tt) * 16 + 8 + 4 * g + hd] = __expf(sc[1]); }
    { const int lb = wid >> 1, hp = wid & 1, l = 32 * lb + r;
      const unsigned trb = (unsigned)(((lane >> 4) & 1) * 32 + (lane & 3) * 8 + (4 * h + ((lane & 15) >> 2)) * 64);
#ifndef SSA_RANK1
#define SSA_RANK1 0
#endif
#ifndef REP_SSADIAG
#define REP_SSADIAG 1
#endif
#ifndef REP_SSAST
#define REP_SSAST 1
#endif
      bf16x8 cf[8];
#pragma unroll
      for (int ks = 0; ks < 8; ++ks) cf[ks] = *(const LAS bf16x8*)(lds + L_C + (2 * ks + h) * KCH + l * 16);
      const size_t tok = tok0 + l; (void)tok;
#pragma unroll 1
      for (int h2 = 0; h2 < 2; ++h2) {
        const int hd = 2 * hp + h2, hg = 4 * g + hd;
        const f32x4 scl = *(const LAS f32x4*)(lds + L_SC + (hd * 128 + l) * 16);
        f32x16 y[2];
        const float dskip = dsk[hg];
        for (int rep_ = 0; rep_ < REP_SSADIAG; ++rep_) { y[0] = zero16(); y[1] = zero16();
        { int lh = l; asm volatile("" : "+v"(lh));
#pragma unroll
        for (int st = 0; st < 4; ++st) {
            bf16x8 bfg[8];
#pragma unroll
            for (int ks = 0; ks < 8; ++ks) bfg[ks] = *(const LAS bf16x8*)(lds + L_B + (2 * ks + h) * KCH + (32 * st + r) * 16);
            f32x16 gt = zero16();
#pragma unroll
            for (int ks = 0; ks < 8; ++ks) gt = __builtin_amdgcn_mfma_f32_32x32x16_bf16(bfg[ks], cf[ks], gt, 0, 0, 0);
            unsigned o[8];
            if (!SSA_RANK1 || st == lb) {
#pragma unroll
                for (int rp = 0; rp < 8; ++rp) { float pw[2];
#pragma unroll
                    for (int e2 = 0; e2 < 2; ++e2) { const int rg = 2 * rp + e2, s = 32 * st + crow(rg, h); const f32x4 scs = *(const LAS f32x4*)(lds + L_SC + (hd * 128 + s) * 16);
                        const int d = s - lh; const bool lt = d < 0;
                        const float arg = lt ? scl[0] - scs[0] : scl[1] - scs[1]; const float coef = lt ? scs[2] : scs[3];
                        float v = gt[rg] * coef * __expf(arg); if (d == 0) v = gt[rg] * (scs[2] + scs[3]) + dskip; pw[e2] = v; }
                    o[rp] = cvtpk(pw[0], pw[1]); }
            } else {
                const bool fw = st < lb; const int ci = fw ? 0 : 1;
                const float ref = *(const LAS float*)(lds + L_SC + (hd * 128 + (fw ? 32 * lb - 1 : 32 * lb + 32)) * 16 + 4 * ci);
                const float al = __expf(scl[ci] - ref);
#pragma unroll
                for (int rp = 0; rp < 8; ++rp) { float pw[2];
#pragma unroll
                    for (int e2 = 0; e2 < 2; ++e2) { const int rg = 2 * rp + e2, s = 32 * st + crow(rg, h); const f32x4 scs = *(const LAS f32x4*)(lds + L_SC + (hd * 128 + s) * 16);
                        pw[e2] = gt[rg] * (scs[2 + ci] * __expf(ref - scs[ci])) * al; }
                    o[rp] = cvtpk(pw[0], pw[1]); }
            }
            const bf16x8 pf0 = __builtin_bit_cast(bf16x8, (v4u){o[0], o[1], o[2], o[3]}), pf1 = __builtin_bit_cast(bf16x8, (v4u){o[4], o[5], o[6], o[7]});
            bf16x8 xa[2][2];
#pragma unroll
            for (int ks2 = 0; ks2 < 2; ++ks2)
#pragma unroll
                for (int pt = 0; pt < 2; ++pt) { const lptr p = lds + L_X + (hd * 2 + pt) * XBLK + trb + (2 * st + ks2) * 1024; const v4i16_t lo = vtr(p), hi = vtr(p + 512);
                    xa[ks2][pt] = (bf16x8){lo[0], lo[1], lo[2], lo[3], hi[0], hi[1], hi[2], hi[3]}; }
#pragma unroll
            for (int ks2 = 0; ks2 < 2; ++ks2)
#pragma unroll
                for (int pt = 0; pt < 2; ++pt) y[pt] = __builtin_amdgcn_mfma_f32_32x32x16_bf16(xa[ks2][pt], ks2 ? pf1 : pf0, y[pt], 0, 0, 0);
        } }
        if (REP_SSADIAG > 1) asm volatile("" :: "v"(y[0]), "v"(y[1])); }
        bf16* yp = YD + (size_t)((b * 32 + c) * 2 + g) * 32768 + (size_t)(hd * 8 * 128 + l) * 8 + 4 * h;
#pragma unroll
        for (int pt = 0; pt < 2; ++pt)
#pragma unroll
            for (int q = 0; q < 4; ++q) { u32x2 o; o.x = cvtpk(y[pt][4 * q], y[pt][4 * q + 1]); o.y = cvtpk(y[pt][4 * q + 2], y[pt][4 * q + 3]); *(u32x2*)(yp + (pt * 4 + q) * 1024) = o; }
      } }
    { const int hd = wid >> 1, dir = wid & 1, hg = 4 * g + hd;
      const unsigned trx = (unsigned)(((lane >> 4) & 1) * 32 + (lane & 3) * 8 + (4 * h + ((lane & 15) >> 2)) * 64);
      const unsigned trk = (unsigned)((2 * ((lane >> 4) & 1) + ((lane & 3) >> 1)) * KCH + (4 * h + ((lane & 15) >> 2)) * 16 + (lane & 1) * 8);
      f32x16 acc[2][4];
#pragma unroll
      for (int pt = 0; pt < 2; ++pt)
#pragma unroll
          for (int nt = 0; nt < 4; ++nt) acc[pt][nt] = zero16();
#pragma unroll 2
      for (int k = 0; k < 8; ++k) {
          const LAS f32x4* wp = (const LAS f32x4*)(lds + L_W + ((hd * 2 + dir) * 128 + 16 * k + 4 * h) * 4);
          const f32x4 w0 = wp[0], w1 = wp[2];
          bf16x8 af[2], bfr[4];
#pragma unroll
          for (int pt = 0; pt < 2; ++pt) { const lptr p = lds + L_X + (hd * 2 + pt) * XBLK + trx + k * 1024; const v4i16_t lo = vtr(p), hi = vtr(p + 512);
              unsigned o[4];
              o[0] = cvtpk(bfl((unsigned short)lo[0]) * w0[0], bfl((unsigned short)lo[1]) * w0[1]); o[1] = cvtpk(bfl((unsigned short)lo[2]) * w0[2], bfl((unsigned short)lo[3]) * w0[3]);
              o[2] = cvtpk(bfl((unsigned short)hi[0]) * w1[0], bfl((unsigned short)hi[1]) * w1[1]); o[3] = cvtpk(bfl((unsigned short)hi[2]) * w1[2], bfl((unsigned short)hi[3]) * w1[3]);
              af[pt] = __builtin_bit_cast(bf16x8, (v4u){o[0], o[1], o[2], o[3]}); }
#pragma unroll
          for (int nt = 0; nt < 4; ++nt) { const lptr p = lds + L_B + (4 * nt) * KCH + trk + k * 256; const v4i16_t lo = vtr(p), hi = vtr(p + 128);
              bfr[nt] = (bf16x8){lo[0], lo[1], lo[2], lo[3], hi[0], hi[1], hi[2], hi[3]}; }
#pragma unroll
          for (int pt = 0; pt < 2; ++pt)
#pragma unroll
              for (int nt = 0; nt < 4; ++nt) acc[pt][nt] = __builtin_amdgcn_mfma_f32_32x32x16_bf16(bfr[nt], af[pt], acc[pt][nt], 0, 0, 0);
      }
      bf16* dp = ST + (size_t)(((b * 32 + c) * 2 + dir) * 8 + hg) * 8192 + r * 8 + 4 * h;
#pragma unroll
      for (int pt = 0; pt < 2; ++pt)
#pragma unroll
          for (int nt = 0; nt < 4; ++nt)
#pragma unroll
              for (int q = 0; q < 4; ++q) { u32x2 o; o.x = cvtpk(acc[pt][nt][4 * q], acc[pt][nt][4 * q + 1]); o.y = cvtpk(acc[pt][nt][4 * q + 2], acc[pt][nt][4 * q + 3]);
                  *(u32x2*)(dp + ((4 * nt + q) * 64 + 32 * pt) * 8) = o; } }
    __syncthreads();
}

__device__ __forceinline__ void ssb_unit(lptr lds, const bf16* __restrict__ Z, const float* __restrict__ nw, const bf16* __restrict__ ST, const bf16* __restrict__ YD, const bf16* __restrict__ CIMG, const float* __restrict__ EX,
                                         bf16* __restrict__ MIX, int b, int c, int g, const int wave_id) {
    const int tid_ = wave_id * 64 + mk_lane();
    const int tid = tid_, lane = tid & 63, wid = __builtin_amdgcn_readfirstlane(tid >> 6), r = lane & 31, h = lane >> 5;
    const int lb = wid >> 1, hp = wid & 1, l = 32 * lb + r;
    const size_t tok = (size_t)b * SEQ + c * 128 + l;
    bf16x8 cf[8];
#pragma unroll
    for (int ks = 0; ks < 8; ++ks) cf[ks] = *(const bf16x8*)(CIMG + (size_t)((b * 32 + c) * 2 + g) * 16384 + (size_t)((2 * ks + h) * 128 + l) * 8);
    float ssum = 0.f;
    unsigned yk[2][2][8];
#pragma unroll
    for (int h2 = 0; h2 < 2; ++h2) {
        const int hd = 2 * hp + h2, hg = 4 * g + hd;
        f32x16 y[2]; y[0] = zero16(); y[1] = zero16();
#pragma unroll
        for (int dir = 0; dir < 2; ++dir) {
            const bf16* sin = ST + (size_t)(((b * 32 + c) * 2 + dir) * 8 + hg) * 8192 + (h * 64 + r) * 8;
            f32x16 yo[2]; yo[0] = zero16(); yo[1] = zero16();
            bf16x8 af[8][2];
#pragma unroll
            for (int ks = 0; ks < 8; ++ks)
#pragma unroll
                for (int pt = 0; pt < 2; ++pt) af[ks][pt] = *(const bf16x8*)(sin + (2 * ks * 64 + 32 * pt) * 8);
            const float e = EX[tok * 16 + dir * 8 + hg];
            __builtin_amdgcn_sched_barrier(0);
#pragma unroll
            for (int ks = 0; ks < 8; ++ks)
#pragma unroll
                for (int pt = 0; pt < 2; ++pt) yo[pt] = __builtin_amdgcn_mfma_f32_32x32x16_bf16(af[ks][pt], cf[ks], yo[pt], 0, 0, 0);
            __builtin_amdgcn_sched_barrier(0);
            y[0] += yo[0] * e; y[1] += yo[1] * e;
        }
        const bf16* zp = Z + tok * NSSD + g * 256 + hd * 64 + 4 * h; const bf16* ydp = YD + (size_t)((b * 32 + c) * 2 + g) * 32768 + (size_t)(hd * 8 * 128 + l) * 8 + 4 * h;
        u32x2 zv[2][4], dv[2][4];
#pragma unroll
        for (int pt = 0; pt < 2; ++pt)
#pragma unroll
            for (int q = 0; q < 4; ++q) { zv[pt][q] = *(const u32x2*)(zp + 32 * pt + 8 * q); dv[pt][q] = *(const u32x2*)(ydp + (pt * 4 + q) * 1024); }
        __builtin_amdgcn_sched_barrier(0);
#pragma unroll
        for (int pt = 0; pt < 2; ++pt)
#pragma unroll
            for (int q = 0; q < 4; ++q) { const float z4[4] = {bfl(zv[pt][q].x), bfh(zv[pt][q].x), bfl(zv[pt][q].y), bfh(zv[pt][q].y)}, d4[4] = {bfl(dv[pt][q].x), bfh(dv[pt][q].x), bfl(dv[pt][q].y), bfh(dv[pt][q].y)}; float yv[4];
#pragma unroll
                for (int i = 0; i < 4; ++i) { yv[i] = (y[pt][4 * q + i] + d4[i]) * silu(z4[i]); ssum += yv[i] * yv[i]; }
                yk[h2][pt][2 * q] = cvtpk(yv[0], yv[1]); yk[h2][pt][2 * q + 1] = cvtpk(yv[2], yv[3]); }
    }
    ssum += __shfl_xor(ssum, 32);
    LAS float* ssx = (LAS float*)(lds + L_W);
    if (h == 0) ssx[hp * 128 + l] = ssum;
    __syncthreads();
    const float rn = rsqrtf((ssx[l] + ssx[128 + l]) * (1.0f / 256.0f) + EPS);
#pragma unroll
    for (int h2 = 0; h2 < 2; ++h2) { const int hd = 2 * hp + h2; const int ch = g * 256 + hd * 64 + 4 * h; bf16* op = MIX + tok * D_MODEL + 512 + ch;
#pragma unroll
        for (int pt = 0; pt < 2; ++pt)
#pragma unroll
            for (int q = 0; q < 4; ++q) { const f32x4 wv = *(const f32x4*)(nw + ch + 32 * pt + 8 * q); const unsigned a0 = yk[h2][pt][2 * q], a1 = yk[h2][pt][2 * q + 1]; u32x2 o;
                o.x = cvtpk(bfl(a0) * rn * wv[0], bfh(a0) * rn * wv[1]); o.y = cvtpk(bfl(a1) * rn * wv[2], bfh(a1) * rn * wv[3]);
                *(u32x2*)(op + 32 * pt + 8 * q) = o; } }
    __syncthreads();
}
}

constexpr int NWAVES = 8;
constexpr int RING_OFF = 0, RING_BYTES = 131072;
constexpr int LDS_BYTES = 163840;
constexpr int LDSCTL_OFF = LDS_BYTES - 1024, MISC_OFF = LDSCTL_OFF + 320;
static_assert(ssd::L_END <= LDSCTL_OFF && attn_body::ATTN_LDS_BYTES <= RING_BYTES, "LDS map");
constexpr int TAB_OFF = RING_BYTES;
#ifndef GEMM_ALIGN
#define GEMM_ALIGN true
#endif
#ifndef GEMM_SP2
#define GEMM_SP2 true
#endif
constexpr int NPHASE = 16;
#ifndef REP_P0
#define REP_P0 1
#endif
#ifndef REP_IN
#define REP_IN 1
#endif
#ifndef REP_S1
#define REP_S1 1
#endif
#ifndef REP_ATT
#define REP_ATT 1
#endif
#ifndef REP_S3
#define REP_S3 1
#endif
#ifndef REP_GU
#define REP_GU 1
#endif
#ifndef REP_OUT0
#define REP_OUT0 1
#endif

struct Frame {
    LAS unsigned char* lds; volatile LAS unsigned* MISC;
    int tid, lane, wave, vcu, G;
};
struct Args { const float* in[17]; float* out; unsigned char* ws; int ph_lo, ph_hi; };

struct ConvDesc { const float* W; const float* ks; bf16* WT; int ldw, k0, srcc0, K, drow0; bool perm; };
struct ConvSrc { const float *win, *wout, *wg, *wu, *wd, *n1, *n2; };
__device__ __forceinline__ ConvDesc conv_desc(const ConvSrc& a, unsigned char* ws, int l, int it) {
    constexpr int I_IN = 16 * 72, I_OUT = 16 * 32, I_GU = 16 * 176;
    ConvDesc d; int r = it;
    if (r < I_IN) { const int kb = r / 72, rb = r % 72, pn = pg8::inproj_ltile(rb >> 3), blk = rb & 7, bj = blk >> 2, wc = blk & 3;
        d.perm = pn <= 2; d.srcc0 = d.perm ? ((pn < 2 ? pn * 256 : 512) + wc * 64 + 32 * bj) : (pn * 8 + blk) * 32;
        d.W = a.win + (size_t)l * D_MODEL * NIN; d.ldw = NIN; d.ks = a.n1 + l * D_MODEL; d.k0 = kb * 64; d.WT = (bf16*)(ws + WS_WIN) + (size_t)l * NINM * D_MODEL; d.K = D_MODEL; d.drow0 = rb * 32; return d; }
    r -= I_IN; d.perm = false;
    if (r < I_OUT) { const int kb = r / 32, rb = r % 32;
        d.W = a.wout + (size_t)l * D_MODEL * D_MODEL; d.ldw = D_MODEL; d.ks = nullptr; d.k0 = kb * 64; d.srcc0 = rb * 32; d.WT = (bf16*)(ws + WS_WOUT) + (size_t)l * D_MODEL * D_MODEL; d.K = D_MODEL; d.drow0 = rb * 32; return d; }
    r -= I_OUT;
    if (r < I_GU) { const int kb = r / 176, rb = r % 176, pn = rb >> 3, blk = rb & 7, bj = blk >> 2, wc = blk & 3;
        d.W = (bj ? a.wu : a.wg) + (size_t)l * D_MODEL * DFF; d.ldw = DFF; d.ks = a.n2 + l * D_MODEL; d.k0 = kb * 64; d.srcc0 = pn * 128 + wc * 32; d.WT = (bf16*)(ws + WS_WGU) + (size_t)l * NGU * D_MODEL; d.K = D_MODEL; d.drow0 = rb * 32; return d; }
    r -= I_GU;
    { const int kb = r / 32, rb = r % 32;
        d.W = a.wd + (size_t)l * DFF * D_MODEL; d.ldw = D_MODEL; d.ks = nullptr; d.k0 = kb * 64; d.srcc0 = rb * 32; d.WT = (bf16*)(ws + WS_WDN) + (size_t)l * D_MODEL * DFF; d.K = DFF; d.drow0 = rb * 32; return d; }
}
__device__ __forceinline__ void conv_load(const ConvDesc& d, f32x4 (&v)[8], float (&kv)[8], int lane) {
    const int r8 = lane >> 3, g = lane & 7, sg = d.perm ? (4 * (g & 1) + (g >> 1)) : g;
    const float* p = d.W + (size_t)(d.k0 + r8) * d.ldw + d.srcc0 + 4 * sg;
#pragma unroll
    for (int i = 0; i < 8; ++i) { v[i] = *(const f32x4*)(p + (size_t)(8 * i) * d.ldw); kv[i] = d.ks ? d.ks[d.k0 + 8 * i + r8] : 1.0f; }
}
__device__ __forceinline__ void conv_finish(const ConvDesc& d, const f32x4 (&v)[8], const float (&kv)[8], LAS float* scr, int lane) {
    const int r8 = lane >> 3, g = lane & 7;
#pragma unroll
    for (int i = 0; i < 8; ++i) { LAS float* s = scr + (8 * i + r8) * 33 + 4 * g; const f32x4 w = v[i] * kv[i]; s[0] = w[0]; s[1] = w[1]; s[2] = w[2]; s[3] = w[3]; }
    LDS_WAIT(); asm volatile("" ::: "memory");
    const int c8 = lane & 7;
#pragma unroll
    for (int j = 0; j < 4; ++j) { const int n = (lane >> 3) + 8 * j; const LAS float* s = scr + (8 * c8) * 33 + n;
        v4u o; o.x = pk2(s[0 * 33], s[1 * 33]); o.y = pk2(s[2 * 33], s[3 * 33]); o.z = pk2(s[4 * 33], s[5 * 33]); o.w = pk2(s[6 * 33], s[7 * 33]);
        *(GAS v4u*)(d.WT + (size_t)(d.drow0 + n) * d.K + d.k0 + 8 * c8) = o; }
    LDS_WAIT(); asm volatile("" ::: "memory");
}
__device__ __forceinline__ void convert_layer_weights(Frame& F, const Args& a, int l, int gw, int NGW) {
    unsigned char* ws = a.ws;
    LAS float* scr = (LAS float*)(F.lds + RING_OFF + F.wave * 16384);
    constexpr int I_L = 16 * 72 + 16 * 32 + 16 * 176 + 44 * 32;
    ConvSrc cs{a.in[2], a.in[11], a.in[13], a.in[14], a.in[15], a.in[1], a.in[12]};
    asm volatile("" : "+s"(cs.win), "+s"(cs.wout), "+s"(cs.wg), "+s"(cs.wu), "+s"(cs.wd), "+s"(cs.n1), "+s"(cs.n2));
    for (int it = gw; it < I_L; it += 3 * NGW) {
        const bool h1 = it + NGW < I_L, h2 = it + 2 * NGW < I_L;
        const ConvDesc d0 = conv_desc(cs, ws, l, it), d1 = conv_desc(cs, ws, l, h1 ? it + NGW : it), d2 = conv_desc(cs, ws, l, h2 ? it + 2 * NGW : it);
        f32x4 v0[8], v1[8], v2[8]; float k0[8], k1[8], k2[8];
        conv_load(d0, v0, k0, F.lane); conv_load(d1, v1, k1, F.lane); conv_load(d2, v2, k2, F.lane);
        __builtin_amdgcn_sched_barrier(0);
        conv_finish(d0, v0, k0, scr, F.lane);
        if (h1) conv_finish(d1, v1, k1, scr, F.lane);
        if (h2) conv_finish(d2, v2, k2, scr, F.lane);
    }
}
__device__ __forceinline__ void p0_prologue(Frame& F, const Args& a) {
    unsigned char* ws = a.ws;
    const int gw = F.vcu * NWAVES + F.wave, NGW = F.G * NWAVES;
#ifndef OPT_A
#define OPT_A 1
#endif
#ifndef REP_CONV
#define REP_CONV 1
#endif
    for (int rc_ = 1; rc_ < REP_CONV; ++rc_) { convert_layer_weights(F, a, 0, gw, NGW); asm volatile("s_waitcnt vmcnt(0)" ::: "memory"); }
    convert_layer_weights(F, a, 0, gw, NGW);
    if (!OPT_A) convert_layer_weights(F, a, 1, gw, NGW);
    for (int e = (F.vcu * NWAVES + F.wave) * 64 + F.lane; e < 2 * 16 * D_MODEL; e += NGW * 64) { const int l = e >> 14, j = (e >> 10) & 15, k = e & 1023;
        ((bf16*)(ws + WS_WDT))[e] = (bf16)f2bf(a.in[2][(size_t)l * D_MODEL * NIN + (size_t)k * NIN + NINM + j] * a.in[1][l * D_MODEL + k]); }
    if (blockIdx.x == 0) { float* tab = (float*)(ws + WS_ROPE);
        for (int i = F.tid; i < 1024; i += NWAVES * 64) { const int pos = i >> 4, j = i & 15; const float inv = powf(10000.f, -(2.0f * (float)j) / 32.f); const float ang = (float)pos * inv; tab[i] = cosf(ang); tab[1024 + i] = sinf(ang); } }
    const float* x = a.in[0]; bf16* XN = (bf16*)(ws + WS_XN); float* SSQ = (float*)(ws + WS_SSQ);
    for (int row = gw; row < M; row += NGW) {
        const f32x4* xr = (const f32x4*)(x + (size_t)row * D_MODEL); float s = 0.f; f32x4 v[4];
#pragma unroll
        for (int j = 0; j < 4; ++j) { v[j] = xr[F.lane + 64 * j]; const f32x4 q = v[j] * v[j]; s += (q[0] + q[1]) + (q[2] + q[3]); }
        s = wave_sum(s);
        unsigned long long* o8 = (unsigned long long*)(XN + (size_t)row * D_MODEL) + F.lane;
#pragma unroll
        for (int j = 0; j < 4; ++j) o8[64 * j] = (unsigned long long)pk2(v[j][0], v[j][1]) | ((unsigned long long)pk2(v[j][2], v[j][3]) << 32);
        if (F.lane < 16) SSQ[(size_t)row * 16 + F.lane] = F.lane == 0 ? s : 0.f;
    }
}

#ifndef OPT_DT
#define OPT_DT 2
#endif
#if OPT_DT == 2
__device__ __forceinline__ void dt_units(Frame& F, const bf16* __restrict__ XN, const bf16* __restrict__ Wdt, const float* __restrict__ SSQ, float* __restrict__ DT, const int tbase, const int gw, const int NGW, const int ntask) {
    const int r16 = F.lane & 15, q = F.lane >> 4;
    constexpr int WROW = 2048 + 16;
    for (int i = F.tid; i < 16 * 128; i += NWAVES * 64) { const int j = i >> 7, c = i & 127; *(LAS v4u*)(F.lds + RING_OFF + j * WROW + c * 16) = *(const v4u*)(Wdt + (size_t)j * D_MODEL + c * 8); }
    __syncthreads();
    const LAS unsigned char* bl = F.lds + RING_OFF + r16 * WROW + q * 16;
    for (int t_ = gw; t_ < ntask; t_ += NGW) { const int task = tbase + t_;
        const bf16* ap = XN + (size_t)(task * 16 + r16) * D_MODEL + 8 * q;
        bf16x8 av[32]; f32x4 sq[4][4];
#pragma unroll
        for (int j = 0; j < 32; ++j) av[j] = *(const bf16x8*)(ap + 32 * j);
#pragma unroll
        for (int rg = 0; rg < 4; ++rg) { const f32x4* sp = (const f32x4*)(SSQ + (size_t)(task * 16 + 4 * q + rg) * 16);
#pragma unroll
            for (int j = 0; j < 4; ++j) sq[rg][j] = sp[j]; }
        __builtin_amdgcn_sched_barrier(0);
        float zf = 0.f; asm volatile("" : "+v"(zf)); f32x4 acc = {zf, zf, zf, zf};
#pragma unroll
        for (int j = 0; j < 32; ++j) { const bf16x8 bv = *(const LAS bf16x8*)(bl + j * 64); acc = __builtin_amdgcn_mfma_f32_16x16x32_bf16(av[j], bv, acc, 0, 0, 0); }
#pragma unroll
        for (int rg = 0; rg < 4; ++rg) { const int tok = task * 16 + 4 * q + rg; const f32x4 s0 = sq[rg][0], s1 = sq[rg][1], s2 = sq[rg][2], s3 = sq[rg][3];
            const float s = ((s0[0] + s0[1]) + (s0[2] + s0[3])) + ((s1[0] + s1[1]) + (s1[2] + s1[3])) + ((s2[0] + s2[1]) + (s2[2] + s2[3])) + ((s3[0] + s3[1]) + (s3[2] + s3[3]));
            DT[(size_t)tok * 16 + r16] = acc[rg] * rsqrtf(s * (1.0f / 1024.0f) + EPS); }
    }
    __syncthreads();
}
#elif OPT_DT
__device__ __forceinline__ void dt_units(Frame& F, const bf16* __restrict__ XN, const bf16* __restrict__ Wdt, const float* __restrict__ SSQ, float* __restrict__ DT) {
    const int gw = F.vcu * NWAVES + F.wave, NGW = F.G * NWAVES, r16 = F.lane & 15, q = F.lane >> 4;
    constexpr int WROW = 2048 + 16;
    for (int i = F.tid; i < 16 * 128; i += NWAVES * 64) { const int j = i >> 7, c = i & 127; *(LAS v4u*)(F.lds + RING_OFF + j * WROW + c * 16) = *(const v4u*)(Wdt + (size_t)j * D_MODEL + c * 8); }
    __syncthreads();
    const LAS unsigned char* bl = F.lds + RING_OFF + r16 * WROW + q * 16;
    for (int task = gw; task < M / 16; task += NGW) {
        const bf16* ap = XN + (size_t)(task * 16 + r16) * D_MODEL + 8 * q;
        float zf = 0.f; asm volatile("" : "+v"(zf)); f32x4 acc = {zf, zf, zf, zf};
#pragma unroll 16
        for (int k0 = 0; k0 < D_MODEL; k0 += 32) { const bf16x8 av = *(const bf16x8*)(ap + k0), bv = *(const LAS bf16x8*)(bl + k0 * 2); acc = __builtin_amdgcn_mfma_f32_16x16x32_bf16(av, bv, acc, 0, 0, 0); }
#pragma unroll
        for (int rg = 0; rg < 4; ++rg) { const int tok = task * 16 + 4 * q + rg; const f32x4* sp = (const f32x4*)(SSQ + (size_t)tok * 16); const f32x4 s0 = sp[0], s1 = sp[1], s2 = sp[2], s3 = sp[3];
            const float s = ((s0[0] + s0[1]) + (s0[2] + s0[3])) + ((s1[0] + s1[1]) + (s1[2] + s1[3])) + ((s2[0] + s2[1]) + (s2[2] + s2[3])) + ((s3[0] + s3[1]) + (s3[2] + s3[3]));
            DT[(size_t)tok * 16 + r16] = acc[rg] * rsqrtf(s * (1.0f / 1024.0f) + EPS); }
    }
    __syncthreads();
}

#else
__device__ __forceinline__ void dt_units(Frame& F, const bf16* __restrict__ XN, const bf16* __restrict__ Wdt, const float* __restrict__ SSQ, float* __restrict__ DT) {
    const int gw = F.vcu * NWAVES + F.wave, NGW = F.G * NWAVES, r16 = F.lane & 15, q = F.lane >> 4;
    for (int task = gw; task < M / 16; task += NGW) {
        const bf16* ap = XN + (size_t)(task * 16 + r16) * D_MODEL + 8 * q; const bf16* bp = Wdt + (size_t)r16 * D_MODEL + 8 * q;
        float zf = 0.f; asm volatile("" : "+v"(zf)); f32x4 acc = {zf, zf, zf, zf};
#pragma unroll 1
        for (int kb = 0; kb < D_MODEL; kb += 256) {
            bf16x8 av[8], bv[8];
#pragma unroll
            for (int j = 0; j < 8; ++j) { av[j] = *(const bf16x8*)(ap + kb + 32 * j); bv[j] = *(const bf16x8*)(bp + kb + 32 * j); }
            __builtin_amdgcn_sched_barrier(0);
#pragma unroll
            for (int j = 0; j < 8; ++j) acc = __builtin_amdgcn_mfma_f32_16x16x32_bf16(av[j], bv[j], acc, 0, 0, 0);
            __builtin_amdgcn_sched_barrier(0);
        }
        f32x4 sq[4][4];
#pragma unroll
        for (int rg = 0; rg < 4; ++rg) { const f32x4* sp = (const f32x4*)(SSQ + (size_t)(task * 16 + 4 * q + rg) * 16);
#pragma unroll
            for (int j = 0; j < 4; ++j) sq[rg][j] = sp[j]; }
        __builtin_amdgcn_sched_barrier(0);
#pragma unroll
        for (int rg = 0; rg < 4; ++rg) { const int tok = task * 16 + 4 * q + rg; const f32x4 s0 = sq[rg][0], s1 = sq[rg][1], s2 = sq[rg][2], s3 = sq[rg][3];
            const float s = ((s0[0] + s0[1]) + (s0[2] + s0[3])) + ((s1[0] + s1[1]) + (s1[2] + s1[3])) + ((s2[0] + s2[1]) + (s2[2] + s2[3])) + ((s3[0] + s3[1]) + (s3[2] + s3[3]));
            DT[(size_t)tok * 16 + r16] = acc[rg] * rsqrtf(s * (1.0f / 1024.0f) + EPS); }
    }
}

#endif
__device__ __forceinline__ void final_rows(Frame& F, float* __restrict__ out, const bf16* __restrict__ XN, const float* __restrict__ SSQ, const float* __restrict__ fw, const int rbase, const int gw, const int NGW, const int nrow) {
    f32x4 w[4];
#pragma unroll
    for (int j = 0; j < 4; ++j) w[j] = ((const f32x4*)fw)[F.lane + 64 * j];
    for (int r_ = gw; r_ < nrow; r_ += NGW) { const int row = rbase + r_;
        const float sv = F.lane < 16 ? SSQ[(size_t)row * 16 + F.lane] : 0.f; const float r = rsqrtf(wave_sum(sv) * (1.0f / 1024.0f) + EPS);
        const unsigned long long* xr = (const unsigned long long*)(XN + (size_t)row * D_MODEL); f32x4* orow = (f32x4*)(out + (size_t)row * D_MODEL);
#pragma unroll
        for (int j = 0; j < 4; ++j) { const unsigned long long v = xr[F.lane + 64 * j]; const unsigned lo = (unsigned)v, hi = (unsigned)(v >> 32);
            const f32x4 x = {__uint_as_float(lo << 16), __uint_as_float(lo & 0xffff0000u), __uint_as_float(hi << 16), __uint_as_float(hi & 0xffff0000u)};
            orow[F.lane + 64 * j] = x * r * w[j]; }
    }
}

constexpr int RST_OFF = TAB_OFF + 8192, QKW_OFF = RST_OFF + 12 * 1024;
template <class Sched>
__device__ __forceinline__ void fill_rstd_table(LAS unsigned char* lds, const float* __restrict__ SSQ, const Sched& S, int tid) {
    pg8::Unit u0; S.next(0, u0);
    f32x4 a[12], b[12]; bool ok[12];
#pragma unroll
    for (int i = 0; i < 12; ++i) { pg8::Unit u; ok[i] = S.next(i, u); const int pm = ok[i] ? u.pm : u0.pm; const float* p = SSQ + (size_t)(pm * 256 + (tid >> 1)) * 16 + (tid & 1) * 8; a[i] = *(const f32x4*)p; b[i] = *(const f32x4*)(p + 4); }
#pragma unroll
    for (int i = 0; i < 12; ++i) { float s = ((a[i][0] + a[i][1]) + (a[i][2] + a[i][3])) + ((b[i][0] + b[i][1]) + (b[i][2] + b[i][3])); s += __shfl_xor(s, 1);
        if (ok[i] && (tid & 1) == 0) ((LAS float*)(lds + RST_OFF))[i * 256 + (tid >> 1)] = rsqrtf(s * (1.0f / 1024.0f) + EPS); }
}
__global__ void __launch_bounds__(NWAVES * 64, 2) mega(Args args) {
    extern __shared__ __attribute__((aligned(16))) unsigned char lds[];
    Frame F;
    F.lds = (LAS unsigned char*)lds; F.MISC = (volatile LAS unsigned*)(F.lds + MISC_OFF);
    F.tid = threadIdx.x; F.lane = F.tid & 63; F.wave = __builtin_amdgcn_readfirstlane(F.tid >> 6);
    F.G = gridDim.x; { const int bx = blockIdx.x; F.vcu = (F.G % 8 == 0) ? (bx % 8) * (F.G / 8) + bx / 8 : bx; }
    for (int u = F.tid; u < (LDS_BYTES - LDSCTL_OFF) / 4; u += NWAVES * 64) ((LAS unsigned*)(F.lds + LDSCTL_OFF))[u] = 0u;
    __syncthreads();
    if (F.tid == 0) { F.MISC[12] = blockIdx.x; F.MISC[13] = (unsigned)F.vcu; F.MISC[14] = 0u; }
    __syncthreads();
    XcdBarrier bar = xcd_barrier_post((unsigned*)(args.ws + WS_CTL) + CW_BAR, F.MISC + 8);
    const int lo = args.ph_lo, hi = args.ph_hi;
#define IN(k) (lo <= (k) && (k) < hi)
#ifndef REP_BAR
#define REP_BAR 1
#endif
#define SEAM(k) do { if (IN(k) && IN((k) + 1)) for (int rb_ = 0; rb_ < REP_BAR; ++rb_) xcd_barrier(bar); } while (0)
#ifndef OPT_AFFINE
#define OPT_AFFINE 1
#endif
#define SEAML(k) do { if (IN(k) && IN((k) + 1)) { if (__builtin_amdgcn_readfirstlane((int)F.MISC[14])) xcd_barrier_local(bar); else xcd_barrier(bar); } } while (0)
#define PHASE_PTRS() int z_ = 0; asm volatile("" : "+s"(z_)); unsigned char* ws = args.ws + z_; (void)ws; \
    Frame Fp = F; Fp.lane = mk_lane(); Fp.tid = F.wave * 64 + Fp.lane; Fp.vcu = __builtin_amdgcn_readfirstlane((int)F.MISC[13]); const int cidx = __builtin_amdgcn_readfirstlane((int)F.MISC[12]); (void)cidx; \
    float* SSQ = (float*)(ws + WS_SSQ); float* DT = (float*)(ws + WS_DT); const float* TAB = (const float*)(ws + WS_ROPE); \
    pg8::bf16_t* XN = (pg8::bf16_t*)(ws + WS_XN); pg8::bf16_t* MIX = (pg8::bf16_t*)(ws + WS_MIX); \
    pg8::bf16_t* Q = (pg8::bf16_t*)(ws + WS_Q); pg8::bf16_t* Kb = (pg8::bf16_t*)(ws + WS_K); pg8::bf16_t* Vb = (pg8::bf16_t*)(ws + WS_V); \
    pg8::bf16_t* Z = (pg8::bf16_t*)(ws + WS_Z); pg8::bf16_t* XR = (pg8::bf16_t*)(ws + WS_XBCR); pg8::bf16_t* HFF = (pg8::bf16_t*)(ws + WS_HFF); \
    (void)SSQ; (void)DT; (void)TAB; (void)XN; (void)MIX; (void)Q; (void)Kb; (void)Vb; (void)Z; (void)XR; (void)HFF
#define AIN(i) (args.in[(i) + z_])

#ifndef DIS_P0
    for (int rep_ = 0; rep_ < REP_P0; ++rep_) if (IN(0)) { Frame Fp = F; Fp.lane = mk_lane(); Fp.tid = F.wave * 64 + Fp.lane; p0_prologue(Fp, args); }
#endif
    SEAM(0);
    if (OPT_AFFINE && IN(0) && IN(1)) {
        if (F.tid == 0 && F.MISC[8 + 2] == 2u) { const unsigned rank = F.MISC[8 + 3]; F.MISC[12] = rank * 8u + bar.x; F.MISC[13] = bar.x * (unsigned)(F.G / 8) + rank; F.MISC[14] = 1u; }
        __syncthreads();
    }
#pragma unroll
    for (int l = 0; l < DEPTH; ++l) {
        const int pb = 1 + 7 * l;
#ifndef DIS_P1
        for (int rep_ = 0; rep_ < REP_IN; ++rep_) if (IN(pb)) {
            PHASE_PTRS();
            pg8::Gemm g{XN, (const pg8::bf16_t*)(ws + WS_WIN) + (size_t)l * NINM * D_MODEL, M, NINM, D_MODEL}; pg8::OrdOrder S; S.init(M, NINM, Fp.G, cidx);
            { LAS float* tl = (LAS float*)(Fp.lds + TAB_OFF); for (int i = Fp.tid; i < 2048; i += NWAVES * 64) tl[i] = TAB[i];
              if (Fp.tid < 128) ((LAS float*)(Fp.lds + QKW_OFF))[Fp.tid] = Fp.tid < 64 ? AIN(3)[l * 64 + Fp.tid] : AIN(4)[l * 64 + Fp.tid - 64]; }
            fill_rstd_table(Fp.lds, SSQ, S, Fp.tid);
            __syncthreads();
#ifndef REP_INGEMM
#define REP_INGEMM 1
#endif
#ifndef IN_VAR
#define IN_VAR 0
#endif
            for (int ri_ = 0; ri_ < REP_INGEMM; ++ri_) {
            pg8::EpiInProj E{Q, Kb, Vb, Z, XR, (const LAS float*)(Fp.lds + RST_OFF), (const LAS float*)(Fp.lds + QKW_OFF), (const LAS float*)(Fp.lds + TAB_OFF), (REP_INGEMM > 1 && ri_ == 0) ? IN_VAR : 0};
            pg8::gemm_phase<pg8::EpiInProj, pg8::OrdOrder, GEMM_ALIGN, GEMM_SP2>(Fp.lds + RING_OFF, g, S, E, F.wave); }
#ifndef REP_DT
#define REP_DT 1
#endif
            const int nun = (M / 256) * (NINM / 256), rem = nun % Fp.G, first = rem, nb = Fp.G - first;
#ifndef OPT_DTLIGHT
#define OPT_DTLIGHT 1
#endif
#if OPT_DT == 2
            { const int gx = cidx & 7, gr = cidx >> 3, gr0 = (OPT_DTLIGHT && Fp.G % 8 == 0 && first % 8 == 0) ? first / 8 : 0, ngr = Fp.G / 8 - gr0;
              if (Fp.G % 8 == 0) { if (gr >= gr0) dt_units(Fp, XN, (const bf16*)(ws + WS_WDT) + (size_t)l * 16 * D_MODEL, SSQ, DT, gx * (M / 16 / 8), (gr - gr0) * NWAVES + Fp.wave, ngr * NWAVES, M / 16 / 8); }
              else dt_units(Fp, XN, (const bf16*)(ws + WS_WDT) + (size_t)l * 16 * D_MODEL, SSQ, DT, 0, cidx * NWAVES + Fp.wave, Fp.G * NWAVES, M / 16); }
#else
            for (int rd_ = 0; rd_ < REP_DT; ++rd_) { dt_units(Fp, XN, (const bf16*)(ws + WS_WDT) + (size_t)l * 16 * D_MODEL, SSQ, DT); if (REP_DT > 1) asm volatile("s_waitcnt vmcnt(0)" ::: "memory"); }
#endif
            if (OPT_A && l + 1 < DEPTH) {
                if (cidx >= first) convert_layer_weights(Fp, args, l + 1, (cidx - first) * NWAVES + Fp.wave, nb * NWAVES);
            }
        }
#endif
        SEAML(pb);
#ifndef OPT_STAGGER
#define OPT_STAGGER 1
#endif
        { const bool attn_first = OPT_STAGGER && __builtin_amdgcn_readfirstlane((int)F.MISC[14]) != 0 && (__builtin_amdgcn_readfirstlane((int)F.MISC[12]) & 1) == 0;
#pragma unroll 1
          for (int st_ = 0; st_ < 2; ++st_) {
            if ((st_ == 0) == attn_first) {
#ifndef DIS_P2
        if (IN(pb + 1)) {
            PHASE_PTRS();
            const int upc = (1024 + Fp.G - 1) / Fp.G;
            for (int rep_ = 0; rep_ < REP_ATT; ++rep_)
            for (int i = 0; i < upc; ++i) { const int gidx = Fp.vcu * upc + i; if (gidx >= 1024) break;
                const int bg = gidx >> 6, r = gidx & 63, b = bg >> 1, h = (bg & 1) * 4 + (r >> 4), qb = r & 15;
#ifdef ATT_NT
                if (REP_ATT > 1 && rep_ == 0) attn_body::attn_unit<8, ATT_NT>(b, h, qb, (const attn_body::bf16*)Q, (const attn_body::bf16*)Kb, (const attn_body::bf16*)Vb, (attn_body::bf16*)MIX, (char*)lds + RING_OFF, F.wave); else
#endif
                attn_body::attn_unit<8>(b, h, qb, (const attn_body::bf16*)Q, (const attn_body::bf16*)Kb, (const attn_body::bf16*)Vb, (attn_body::bf16*)MIX, (char*)lds + RING_OFF, F.wave); }
        }
#endif
            } else {
#ifndef DIS_P2A
        if (IN(pb + 1)) {
            PHASE_PTRS();
#if !defined(NAIVE_SSD) && !defined(DIS_S1)
#ifndef SSD_SPLIT
#define SSD_SPLIT 1
#endif
            for (int rep_ = 0; rep_ < REP_S1; ++rep_) { const int upc = (512 + Fp.G - 1) / Fp.G;
              for (int i = 0; i < upc; ++i) { const int u = Fp.vcu * upc + i; if (u >= 512) break;
#if SSD_SPLIT
                  ssd::ssa_unit(Fp.lds, XR, DT, AIN(5) + (size_t)l * 5 * NCONV, AIN(6) + l * NCONV, AIN(7) + l * 16, AIN(8) + l * 16, AIN(9) + l * 8, (bf16*)(ws + WS_ST), (float*)(ws + WS_CD), (bf16*)(ws + WS_YD), (bf16*)(ws + WS_CIMG), (float*)(ws + WS_EX), u >> 6, (u >> 1) & 31, u & 1, F.wave); } }
#else
                  ssd::s1_unit(Fp.lds, XR, DT, AIN(5) + (size_t)l * 5 * NCONV, AIN(6) + l * NCONV, AIN(7) + l * 16, AIN(8) + l * 16, (bf16*)(ws + WS_ST), (float*)(ws + WS_CD), u >> 6, (u >> 1) & 31, u & 1, F.wave); } }
#endif
#endif
        }
#endif
        SEAML(pb + 1);
#if !defined(NAIVE_SSD) && !defined(DIS_S2)
        if (IN(pb + 2)) { PHASE_PTRS(); ssd::s2_scan((bf16*)(ws + WS_ST), (const float*)(ws + WS_CD), Fp.vcu * (NWAVES * 64) + Fp.tid, Fp.G * NWAVES * 64); }
#endif
        SEAML(pb + 2);
#if !defined(NAIVE_SSD) && !defined(DIS_S3)
        if (IN(pb + 3)) {
            PHASE_PTRS();
            const int upc = (512 + Fp.G - 1) / Fp.G;
            for (int rep_ = 0; rep_ < REP_S3; ++rep_)
            for (int i = 0; i < upc; ++i) { const int u = Fp.vcu * upc + i; if (u >= 512) break;
#if SSD_SPLIT
                ssd::ssb_unit(Fp.lds, Z, AIN(10) + l * NSSD, (const bf16*)(ws + WS_ST), (const bf16*)(ws + WS_YD), (const bf16*)(ws + WS_CIMG), (const float*)(ws + WS_EX), MIX, u >> 6, (u >> 1) & 31, u & 1, F.wave); }
#else
                ssd::s3_unit(Fp.lds, XR, DT, Z, AIN(5) + (size_t)l * 5 * NCONV, AIN(6) + l * NCONV, AIN(7) + l * 16, AIN(8) + l * 16, AIN(9) + l * 8, AIN(10) + l * NSSD, (const bf16*)(ws + WS_ST), MIX, u >> 6, (u >> 1) & 31, u & 1, F.wave); }
#endif
        }
#endif
            }
            __syncthreads();
          }
        }
        SEAML(pb + 3);
#ifndef DIS_P4
        for (int rep_ = 0; rep_ < (l == 0 ? REP_OUT0 : 1); ++rep_) if (IN(pb + 4)) {
            PHASE_PTRS();
            pg8::Gemm g{MIX, (const pg8::bf16_t*)(ws + WS_WOUT) + (size_t)l * D_MODEL * D_MODEL, M, D_MODEL, D_MODEL}; pg8::StaticOrder S; S.init(M, D_MODEL, Fp.G, cidx);
            pg8::EpiResid E{l == 0 ? AIN(0) : (const float*)nullptr, XN, SSQ};
            pg8::gemm_phase<pg8::EpiResid, pg8::StaticOrder, GEMM_ALIGN, GEMM_SP2>(Fp.lds + RING_OFF, g, S, E, F.wave);
        }
#endif
        SEAM(pb + 4);
#ifndef DIS_P5
        for (int rep_ = 0; rep_ < REP_GU; ++rep_) if (IN(pb + 5)) {
            PHASE_PTRS();
#ifdef CLKPROBE
            unsigned long long ck0 = 0, rt0 = 0; if (l == CLKPROBE_L && blockIdx.x == 0 && F.wave == 0) { ck0 = __builtin_amdgcn_s_memtime(); rt0 = __builtin_amdgcn_s_memrealtime(); }
#endif
#ifndef GU_WGM
#define GU_WGM 8
#endif
#ifndef GU_WGM_P
#define GU_WGM_P GU_WGM
#endif
#ifndef GU_N
#define GU_N NGU
#endif
#ifndef GU_K
#define GU_K D_MODEL
#endif
            pg8::Gemm g{XN, (const pg8::bf16_t*)(ws + WS_WGU) + (size_t)l * NGU * D_MODEL, M, (REP_GU > 1 && rep_ == 0) ? GU_N : NGU, (REP_GU > 1 && rep_ == 0) ? GU_K : D_MODEL}; pg8::OrdOrder S; S.init(M, (REP_GU > 1 && rep_ == 0) ? GU_N : NGU, Fp.G, cidx, (REP_GU > 1 && rep_ == 0) ? GU_WGM_P : GU_WGM);
            fill_rstd_table(Fp.lds, SSQ, S, Fp.tid);
            __syncthreads();
#ifndef GU_VAR
#define GU_VAR 0
#endif
            pg8::EpiSwiglu E{HFF, (const LAS float*)(Fp.lds + RST_OFF), (REP_GU > 1 && rep_ == 0) ? GU_VAR : 0};
            pg8::gemm_phase<pg8::EpiSwiglu, pg8::OrdOrder, GEMM_ALIGN, GEMM_SP2>(Fp.lds + RING_OFF, g, S, E, F.wave);
#ifdef CLKPROBE
            if (l == CLKPROBE_L && blockIdx.x == 0 && F.wave == 0) { const unsigned long long ck1 = __builtin_amdgcn_s_memtime(), rt1 = __builtin_amdgcn_s_memrealtime();
                if (Fp.lane == 0) F.MISC[16] = (unsigned)(((ck1 - ck0) * 10000ull) / (rt1 - rt0 + 1ull)); }
#endif
        }
#endif
        SEAML(pb + 5);
#ifndef DIS_P6
        if (IN(pb + 6)) {
            PHASE_PTRS();
            pg8::Gemm g{HFF, (const pg8::bf16_t*)(ws + WS_WDN) + (size_t)l * D_MODEL * DFF, M, D_MODEL, DFF}; pg8::StaticOrder S; S.init(M, D_MODEL, Fp.G, cidx);
            pg8::EpiResid E{nullptr, XN, SSQ};
            pg8::gemm_phase<pg8::EpiResid, pg8::StaticOrder, GEMM_ALIGN, GEMM_SP2>(Fp.lds + RING_OFF, g, S, E, F.wave);
        }
#endif
        if (l + 1 < DEPTH) SEAM(pb + 6); else SEAML(pb + 6);
    }
    if (IN(15)) { PHASE_PTRS();
        if (Fp.G % 8 == 0) final_rows(Fp, args.out, XN, SSQ, AIN(16), (cidx & 7) * (M / 8), (cidx >> 3) * NWAVES + Fp.wave, (Fp.G / 8) * NWAVES, M / 8);
        else final_rows(Fp, args.out, XN, SSQ, AIN(16), 0, cidx * NWAVES + Fp.wave, Fp.G * NWAVES, M); }
#ifdef CLKPROBE
    if (hi == NPHASE && blockIdx.x == 0 && F.wave == 0) { const unsigned ticks = F.MISC[16]; const unsigned long long s0 = __builtin_amdgcn_s_memrealtime(); while (__builtin_amdgcn_s_memrealtime() - s0 < (unsigned long long)ticks) __builtin_amdgcn_s_sleep(8); }
#endif
#undef PHASE_PTRS
#undef AIN
#undef IN
#undef SEAM
#undef SEAML
}

extern "C" void kernel_launch(void* const* d_in, const int* in_sizes, int n_in, void* d_out, int out_size, void* d_ws, size_t ws_size, hipStream_t stream) {
    static int grid = 0;
    if (grid == 0) {
        int dev = 0, cus = 0;
        if (hipGetDevice(&dev) != hipSuccess || hipDeviceGetAttribute(&cus, hipDeviceAttributeMultiprocessorCount, dev) != hipSuccess) { fprintf(stderr, "device query failed\n"); grid = -1; return; }
        if (hipFuncSetAttribute((const void*)mega, hipFuncAttributeMaxDynamicSharedMemorySize, LDS_BYTES) != hipSuccess) { fprintf(stderr, "hipFuncSetAttribute failed\n"); grid = -1; return; }
        (void)hipGetLastError();
        grid = cus;
    }
    if (grid < 0) return;
    unsigned char* ws = (unsigned char*)d_ws; float* out = (float*)d_out;
    (void)hipMemsetAsync(ws + WS_CTL, 0, CTL_ZERO_BYTES, stream);
    Args a{};
    for (int i = 0; i < 17; ++i) a.in[i] = (const float*)d_in[i];
    a.out = out; a.ws = ws;
    auto run = [&](int lo, int hi) { a.ph_lo = lo; a.ph_hi = hi; hipLaunchKernelGGL(mega, dim3(grid), dim3(NWAVES * 64), LDS_BYTES, stream, a); };
#ifdef MULTI_LAUNCH
    run(0, 1);
    for (int l = 0; l < DEPTH; ++l) { const int pb = 1 + 7 * l; for (int k = 0; k < 7; ++k) run(pb + k, pb + k + 1); }
    run(15, 16);
#else
    run(0, NPHASE);
#endif
}
```

```cpp
#include <hip/hip_runtime.h>
#include <cstdint>
#include <cstdio>

constexpr int D_MODEL = 1024, BATCH = 8, SEQ = 4096, DEPTH = 2, M = BATCH * SEQ;
constexpr int NQ = 512, NKV = 128, NSSD = 512, NCONV = 1024, NIN = 2320, NINM = 2304;
constexpr int DFF = 2816, NGU = 2 * DFF;
constexpr float EPS = 1e-6f;
constexpr float C2 = 0.125f * 1.4426950408889634f;

constexpr size_t MiB = 1u << 20;
constexpr size_t WS_CTL = 0, CTL_ZERO_BYTES = 1 * MiB;
constexpr size_t WS_SSQ = 1 * MiB;
constexpr size_t WS_DT = 3 * MiB;
constexpr size_t WS_CD = 5 * MiB;
constexpr size_t WS_ROPE = 5 * MiB + 512 * 1024;
constexpr size_t WS_WIN = 6 * MiB;
constexpr size_t WS_WDT = 15 * MiB;
constexpr size_t WS_WOUT = 16 * MiB;
constexpr size_t WS_WGU = 20 * MiB;
constexpr size_t WS_WDN = 42 * MiB;
constexpr size_t WS_XN = 56 * MiB;
constexpr size_t WS_MIX = 120 * MiB;
constexpr size_t WS_BIG = 184 * MiB, BIG_B = 22 * MiB;
constexpr size_t WS_XBCR = WS_BIG;
constexpr size_t WS_ST = WS_BIG + 8 * MiB;
constexpr size_t WS_YD = WS_BIG + 16 * MiB;
constexpr size_t WS_CIMG = WS_BIG + 20 * MiB;
constexpr size_t XADJ = (BIG_B - 8 * MiB) / 2, SADJ = (BIG_B - 8 * MiB) / 2, YADJ = (BIG_B - 4 * MiB) / 2, CADJ = (BIG_B - 2 * MiB) / 2;
constexpr size_t WS_HFF = WS_BIG;
constexpr size_t WS_Q = 360 * MiB;
constexpr size_t WS_K = 392 * MiB;
constexpr size_t WS_V = 400 * MiB;
constexpr size_t WS_Z = 408 * MiB;
constexpr size_t WS_EX = 440 * MiB;
constexpr int CW_BAR = 4096;
constexpr int CW_PANEL = 32768;

#ifdef LOOP_ALIGN
#define LOOP_ALIGN_STR2(x) #x
#define LOOP_ALIGN_STR1(x) LOOP_ALIGN_STR2(x)
#define LOOP_ALIGN_STR LOOP_ALIGN_STR1(LOOP_ALIGN)
#endif
__device__ __forceinline__ int mk_lane() { int l; asm volatile("v_mbcnt_lo_u32_b32 %0, -1, 0\n\tv_mbcnt_hi_u32_b32 %0, -1, %0" : "=v"(l)); return l; }
namespace pg8 {
#define PG8_LAS __attribute__((address_space(3)))
typedef unsigned short bf16_t;
typedef short bf16x8 __attribute__((ext_vector_type(8)));
typedef float f32x4 __attribute__((ext_vector_type(4)));
typedef unsigned u32x4 __attribute__((ext_vector_type(4)));
constexpr int BM = 256, BK = 64, HALF = 128, HTB = HALF * BK * 2  , STAGE_BYTES = 8 * HTB, NXCD = 8, WGM = 8;

__host__ __device__ __forceinline__ int lds_byte(int r, int c) { const int st = (r >> 4) * 2 + (c >> 5), rr = r & 15, cc = c & 31, ob = rr * 64 + cc * 2; return st * 1024 + (ob ^ (((ob >> 9) & 1) << 5)); }
__host__ __device__ __forceinline__ void stage_rc(int b, int& R, int& C) { const int st = b / 1024, sb = b % 1024, swz = sb ^ (((sb >> 9) & 1) << 5); R = (st >> 1) * 16 + swz / 64; C = (st & 1) * 32 + (swz % 64) / 2; }
__host__ __device__ __forceinline__ int perm32(int rho) { const int n = rho >> 4, i = rho & 15; return 8 * (i >> 2) + 4 * n + (i & 3); }

struct Unit { int pm, pn, ord; };
struct Gemm { const bf16_t* A; const bf16_t* Bt; int M, N, K; };

struct StaticOrder {
    int nM, nN, nwg, G, c, wgm;
    __host__ __device__ void init(int M, int N, int G_, int c_, int wgm_ = WGM) { nM = M / BM; nN = N / BM; nwg = nM * nN; G = G_; c = c_; wgm = wgm_; }
    __host__ __device__ bool next(int i, Unit& u) const {
        const long L = (long)i * G + c; if (L >= nwg) return false;
        int wgid = (int)L; { const int q = nwg / NXCD, r = nwg % NXCD, xcd = wgid % NXCD, off = wgid / NXCD; wgid = (xcd < r ? xcd * (q + 1) : r * (q + 1) + (xcd - r) * q) + off; }
        const int nig = wgm * nN, gid = wgid / nig, fm = gid * wgm, gsz = (nM - fm) < wgm ? (nM - fm) : wgm;
        u.pm = fm + ((wgid % nig) % gsz); u.pn = (wgid % nig) / gsz; return true;
    }
    __device__ __forceinline__ void a_ready(const Unit&) const {}
    __device__ __forceinline__ void done(const Unit&) const {}
};

__device__ __forceinline__ unsigned cvt_pk_bf16(float lo, float hi) { unsigned r; asm volatile("v_cvt_pk_bf16_f32 %0, %1, %2" : "=v"(r) : "v"(lo), "v"(hi)); return r; }
typedef float f32x2 __attribute__((ext_vector_type(2)));
typedef unsigned u32x2 __attribute__((ext_vector_type(2)));
__device__ __forceinline__ float sum_fq(float s) {
    { const auto r = __builtin_amdgcn_permlane16_swap(__float_as_uint(s), __float_as_uint(s), false, false); s = __uint_as_float(r[0]) + __uint_as_float(r[1]); }
    { const auto r = __builtin_amdgcn_permlane32_swap(__float_as_uint(s), __float_as_uint(s), false, false); s = __uint_as_float(r[0]) + __uint_as_float(r[1]); }
    return s;
}
__device__ __forceinline__ void rows_rstd(float (&rs)[2][4], const float* __restrict__ SSQ, int row0, int fq) {
    f32x4 p[2][4];
#pragma unroll
    for (int ai = 0; ai < 2; ++ai)
#pragma unroll
        for (int m = 0; m < 4; ++m) p[ai][m] = *(const f32x4*)(SSQ + (size_t)(row0 + ai * HALF + m * 16) * 16 + 4 * fq);
#pragma unroll
    for (int ai = 0; ai < 2; ++ai)
#pragma unroll
        for (int m = 0; m < 4; ++m) { const float s = sum_fq((p[ai][m][0] + p[ai][m][1]) + (p[ai][m][2] + p[ai][m][3])); rs[ai][m] = rsqrtf(s * (1.0f / 1024.0f) + EPS); }
}
struct OrdOrder : StaticOrder { __host__ __device__ bool next(int i, Unit& u) const { const bool ok = StaticOrder::next(i, u); u.ord = i; return ok; } };
__device__ __forceinline__ void rows_rstd_lds(float (&rs)[2][4], const PG8_LAS float* rst, const Unit& u, int wr, int fr) {
    const PG8_LAS float* p = rst + u.ord * 256 + wr * 64 + fr;
#pragma unroll
    for (int ai = 0; ai < 2; ++ai)
#pragma unroll
        for (int m = 0; m < 4; ++m) rs[ai][m] = p[ai * HALF + m * 16];
}
#ifndef OPT_TILEMAP
#define OPT_TILEMAP 1
#endif
__host__ __device__ __forceinline__ int inproj_ltile(int pn) { return OPT_TILEMAP ? (int)((0x872654130ULL >> (4 * pn)) & 15ULL) : pn; }
struct EpiInProj {
    static constexpr bool PERM = true, AFTER_DRAIN = false;
    bf16_t *Q, *Kb, *Vb, *Z, *XR; const PG8_LAS float *rst, *qkw; const PG8_LAS float* tab;
    __device__ __forceinline__ void operator()(const f32x4 (&acc)[2][2][4][2], const Unit& u, int wr, int wc, int fr, int fq) const {
        const int row0 = u.pm * BM + wr * 64 + fr, lp = inproj_ltile(u.pn);
        float rs[2][4]; rows_rstd_lds(rs, rst, u, wr, fr);
        if (lp >= 3) {
            bf16_t* base; int ld;
            if (lp < 5) { base = Z + (lp - 3) * 256; ld = NSSD; } else { base = XR + (size_t)(u.pm >> 4) * XADJ + (lp - 5) * 256; ld = NCONV; }
            base += wc * 32 + 8 * fq;
#pragma unroll
            for (int ai = 0; ai < 2; ++ai)
#pragma unroll
                for (int m = 0; m < 4; ++m) { const int row = row0 + ai * HALF + m * 16; const float r = rs[ai][m]; bf16_t* rp = base + (size_t)row * ld;
#pragma unroll
                    for (int bj = 0; bj < 2; ++bj) { const f32x4 v0 = acc[ai][bj][m][0] * r, v1 = acc[ai][bj][m][1] * r; u32x4 w; w.x = cvt_pk_bf16(v0[0], v0[1]); w.y = cvt_pk_bf16(v0[2], v0[3]); w.z = cvt_pk_bf16(v1[0], v1[1]); w.w = cvt_pk_bf16(v1[2], v1[3]);
                        *(u32x4*)(rp + bj * HALF) = w; } }
        } else if (lp == 2 && wc >= 2) {
            bf16_t* base = Vb + (wc - 2) * 64 + 4 * fq;
#pragma unroll
            for (int ai = 0; ai < 2; ++ai)
#pragma unroll
                for (int m = 0; m < 4; ++m) { const int row = row0 + ai * HALF + m * 16; const float r = rs[ai][m]; bf16_t* rp = base + (size_t)row * NKV;
#pragma unroll
                    for (int bj = 0; bj < 2; ++bj)
#pragma unroll
                        for (int n = 0; n < 2; ++n) { const f32x4 v = acc[ai][bj][m][n] * r; u32x2 w; w.x = cvt_pk_bf16(v[0], v[1]); w.y = cvt_pk_bf16(v[2], v[3]); *(u32x2*)(rp + 32 * bj + 16 * n) = w; } }
        } else {
            const bool isq = lp < 2; const PG8_LAS float* wp = isq ? qkw : qkw + 64; const float osc = isq ? C2 : 1.0f;
            bf16_t* base = isq ? Q + (lp * 4 + wc) * 64 + 4 * fq : Kb + wc * 64 + 4 * fq; const int ld = isq ? NQ : NKV;
            f32x4 wv[2][2];
#pragma unroll
            for (int bj = 0; bj < 2; ++bj)
#pragma unroll
                for (int n = 0; n < 2; ++n) wv[bj][n] = *(const PG8_LAS f32x4*)(wp + 32 * bj + 16 * n + 4 * fq) * osc;
            const int p0 = (u.pm * 4 + wr) & 63;
#pragma unroll
            for (int ai = 0; ai < 2; ++ai) {
                const f32x4 c0 = *(const PG8_LAS f32x4*)(tab + (p0 + 2 * ai) * 16 + 4 * fq), s0 = *(const PG8_LAS f32x4*)(tab + 1024 + (p0 + 2 * ai) * 16 + 4 * fq);
#pragma unroll
                for (int mh = 0; mh < 2; ++mh) {
                    f32x4 c1[2], s1[2];
#pragma unroll
                    for (int mm = 0; mm < 2; ++mm) { c1[mm] = *(const PG8_LAS f32x4*)(tab + (fr + 32 * mh + 16 * mm) * 16 + 4 * fq); s1[mm] = *(const PG8_LAS f32x4*)(tab + 1024 + (fr + 32 * mh + 16 * mm) * 16 + 4 * fq); }
#pragma unroll
                    for (int mm = 0; mm < 2; ++mm) { const int m = 2 * mh + mm, row = row0 + ai * HALF + m * 16; const float r = rs[ai][m]; bf16_t* rp = base + (size_t)row * ld;
                        float ss = 0.f;
#pragma unroll
                        for (int bj = 0; bj < 2; ++bj)
#pragma unroll
                            for (int n = 0; n < 2; ++n) { const f32x4 q2 = acc[ai][bj][m][n] * acc[ai][bj][m][n]; ss += (q2[0] + q2[1]) + (q2[2] + q2[3]); }
                        ss = sum_fq(ss);
                        const float sc = r * rsqrtf(ss * (r * r) * (1.0f / 64.0f) + EPS);
#pragma unroll
                        for (int bj = 0; bj < 2; ++bj) {
                            const f32x4 cs = (bj ? c1[mm] : c0) * sc, sn = (bj ? s1[mm] : s0) * sc;
                            const f32x4 y0 = acc[ai][bj][m][0] * wv[bj][0], y1 = acc[ai][bj][m][1] * wv[bj][1];
                            const f32x4 o0 = y0 * cs - y1 * sn, o1 = y1 * cs + y0 * sn;
                            u32x2 w0, w1; w0.x = cvt_pk_bf16(o0[0], o0[1]); w0.y = cvt_pk_bf16(o0[2], o0[3]); w1.x = cvt_pk_bf16(o1[0], o1[1]); w1.y = cvt_pk_bf16(o1[2], o1[3]);
                            *(u32x2*)(rp + 32 * bj) = w0; *(u32x2*)(rp + 32 * bj + 16) = w1; } } } }
        }
    }
};
struct EpiResid {
    static constexpr bool PERM = true, AFTER_DRAIN = false;
    const float* resf; bf16_t* XN; float* SSQ;
    __device__ __forceinline__ void operator()(const f32x4 (&acc)[2][2][4][2], const Unit& u, int wr, int wc, int fr, int fq) const {
        const int row0 = u.pm * BM + wr * 64 + fr, col0 = u.pn * BM + wc * 32 + 8 * fq;
#pragma unroll
        for (int ai = 0; ai < 2; ++ai) {
            f32x4 r[4][2][2];
            if (resf) {
#pragma unroll
                for (int m = 0; m < 4; ++m)
#pragma unroll
                    for (int bj = 0; bj < 2; ++bj) { const float* p = resf + (size_t)(row0 + ai * HALF + m * 16) * D_MODEL + col0 + bj * HALF; r[m][bj][0] = *(const f32x4*)p; r[m][bj][1] = *(const f32x4*)(p + 4); }
            } else {
                u32x4 w[4][2];
#pragma unroll
                for (int m = 0; m < 4; ++m)
#pragma unroll
                    for (int bj = 0; bj < 2; ++bj) w[m][bj] = *(const u32x4*)(XN + (size_t)(row0 + ai * HALF + m * 16) * D_MODEL + col0 + bj * HALF);
#pragma unroll
                for (int m = 0; m < 4; ++m)
#pragma unroll
                    for (int bj = 0; bj < 2; ++bj) { const u32x4 x = w[m][bj];
                        r[m][bj][0] = (f32x4){__uint_as_float(x.x << 16), __uint_as_float(x.x & 0xffff0000u), __uint_as_float(x.y << 16), __uint_as_float(x.y & 0xffff0000u)};
                        r[m][bj][1] = (f32x4){__uint_as_float(x.z << 16), __uint_as_float(x.z & 0xffff0000u), __uint_as_float(x.w << 16), __uint_as_float(x.w & 0xffff0000u)}; }
            }
#pragma unroll
            for (int m = 0; m < 4; ++m) { const int row = row0 + ai * HALF + m * 16; const size_t off = (size_t)row * D_MODEL + col0; float ss = 0.f;
#pragma unroll
                for (int bj = 0; bj < 2; ++bj) { const f32x4 x0 = r[m][bj][0] + acc[ai][bj][m][0], x1 = r[m][bj][1] + acc[ai][bj][m][1];
                    const f32x4 q0 = x0 * x0, q1 = x1 * x1; ss += ((q0[0] + q0[1]) + (q0[2] + q0[3])) + ((q1[0] + q1[1]) + (q1[2] + q1[3]));
                    u32x4 w; w.x = cvt_pk_bf16(x0[0], x0[1]); w.y = cvt_pk_bf16(x0[2], x0[3]); w.z = cvt_pk_bf16(x1[0], x1[1]); w.w = cvt_pk_bf16(x1[2], x1[3]);
                    *(u32x4*)(XN + off + bj * HALF) = w; }
                ss = sum_fq(ss);
                if (fq == 0) SSQ[(size_t)row * 16 + u.pn * 4 + wc] = ss; }
        }
    }
};
struct EpiResidFinal {
    static constexpr bool PERM = true, AFTER_DRAIN = false;
    const bf16_t* XN; float* SSQ; float* out; const float* fw; unsigned* pc; PG8_LAS float* rtab; unsigned* tmo;
    __device__ __forceinline__ void operator()(f32x4 (&acc)[2][2][4][2], const Unit& u, int wr, int wc, int fr, int fq) const {
        const int row0 = u.pm * BM + wr * 64 + fr, col0 = u.pn * BM + wc * 32 + 8 * fq, t = (wr * 4 + wc) * 64 + fq * 16 + fr;
#pragma unroll
        for (int ai = 0; ai < 2; ++ai) {
            u32x4 w[4][2];
#pragma unroll
            for (int m = 0; m < 4; ++m)
#pragma unroll
                for (int bj = 0; bj < 2; ++bj) w[m][bj] = *(const u32x4*)(XN + (size_t)(row0 + ai * HALF + m * 16) * D_MODEL + col0 + bj * HALF);
#pragma unroll
            for (int m = 0; m < 4; ++m) { const int row = row0 + ai * HALF + m * 16; float ss = 0.f;
#pragma unroll
                for (int bj = 0; bj < 2; ++bj) { const u32x4 x = w[m][bj];
                    acc[ai][bj][m][0] += (f32x4){__uint_as_float(x.x << 16), __uint_as_float(x.x & 0xffff0000u), __uint_as_float(x.y << 16), __uint_as_float(x.y & 0xffff0000u)};
                    acc[ai][bj][m][1] += (f32x4){__uint_as_float(x.z << 16), __uint_as_float(x.z & 0xffff0000u), __uint_as_float(x.w << 16), __uint_as_float(x.w & 0xffff0000u)};
                    const f32x4 q0 = acc[ai][bj][m][0] * acc[ai][bj][m][0], q1 = acc[ai][bj][m][1] * acc[ai][bj][m][1]; ss += ((q0[0] + q0[1]) + (q0[2] + q0[3])) + ((q1[0] + q1[1]) + (q1[2] + q1[3])); }
                ss = sum_fq(ss);
                if (fq == 0) SSQ[(size_t)row * 16 + u.pn * 4 + wc] = ss; }
        }
        asm volatile("s_waitcnt vmcnt(0)" ::: "memory");
        __builtin_amdgcn_s_barrier();
        if (t == 0) { (void)__hip_atomic_fetch_add(&pc[u.pm], 1u, __ATOMIC_RELAXED, __HIP_MEMORY_SCOPE_AGENT);
            unsigned sp = 0; while (__hip_atomic_load(&pc[u.pm], __ATOMIC_RELAXED, __HIP_MEMORY_SCOPE_AGENT) < 4u) { __builtin_amdgcn_s_sleep(1);
                if ((++sp & 255u) == 0u) { if (__hip_atomic_load(tmo, __ATOMIC_RELAXED, __HIP_MEMORY_SCOPE_AGENT)) break; if (sp > (1u << 18)) { atomicAdd(tmo, 1u); break; } } } }
        __builtin_amdgcn_s_barrier();
        { const int row = t >> 1, hf = t & 1; const unsigned* sp = (const unsigned*)(SSQ + (size_t)(u.pm * BM + row) * 16 + hf * 8); float s = 0.f;
#pragma unroll
          for (int i = 0; i < 8; ++i) s += __uint_as_float(__hip_atomic_load(sp + i, __ATOMIC_RELAXED, __HIP_MEMORY_SCOPE_AGENT));
          s += __shfl_xor(s, 1);
          if (hf == 0) rtab[row] = rsqrtf(s * (1.0f / 1024.0f) + EPS); }
        asm volatile("s_waitcnt lgkmcnt(0)" ::: "memory");
        __builtin_amdgcn_s_barrier();
        f32x4 wf[2][2];
#pragma unroll
        for (int bj = 0; bj < 2; ++bj) { wf[bj][0] = *(const f32x4*)(fw + col0 + bj * HALF); wf[bj][1] = *(const f32x4*)(fw + col0 + bj * HALF + 4); }
#pragma unroll
        for (int ai = 0; ai < 2; ++ai)
#pragma unroll
            for (int m = 0; m < 4; ++m) { const int rl = wr * 64 + fr + ai * HALF + m * 16; const float r = rtab[rl]; float* op = out + (size_t)(u.pm * BM + rl) * D_MODEL + col0;
#pragma unroll
                for (int bj = 0; bj < 2; ++bj) { *(f32x4*)(op + bj * HALF) = acc[ai][bj][m][0] * r * wf[bj][0]; *(f32x4*)(op + bj * HALF + 4) = acc[ai][bj][m][1] * r * wf[bj][1]; } }
    }
};
#ifndef OPT_NT_H
#define OPT_NT_H 0
#endif
#if OPT_NT_H
#define EPI_STORE16(p, v) __builtin_nontemporal_store((v), (u32x4*)(p))
#else
#define EPI_STORE16(p, v) (*(u32x4*)(p) = (v))
#endif
struct EpiSwiglu {
    static constexpr bool PERM = true, AFTER_DRAIN = false;
    bf16_t* H; const PG8_LAS float* rst; int var;
    __device__ __forceinline__ void operator()(const f32x4 (&acc)[2][2][4][2], const Unit& u, int wr, int wc, int fr, int fq) const {
        if (var == 3) return;
        const int row0 = u.pm * BM + wr * 64 + fr, col0 = u.pn * HALF + wc * 32 + 8 * fq;
        float rs[2][4];
        if (var == 1) {
#pragma unroll
            for (int ai = 0; ai < 2; ++ai)
#pragma unroll
                for (int m = 0; m < 4; ++m) rs[ai][m] = 1.0f;
        } else rows_rstd_lds(rs, rst, u, wr, fr);
#pragma unroll
        for (int ai = 0; ai < 2; ++ai)
#pragma unroll
            for (int m = 0; m < 4; ++m) { const int row = row0 + ai * HALF + m * 16; const float r = rs[ai][m]; unsigned w[4];
#pragma unroll
                for (int n = 0; n < 2; ++n) { const f32x4 g = acc[ai][0][m][n] * r, up = acc[ai][1][m][n] * r; float h[4];
#pragma unroll
                    for (int i = 0; i < 4; ++i) h[i] = g[i] * __builtin_amdgcn_rcpf(1.0f + __builtin_amdgcn_exp2f(-1.4426950408889634f * g[i])) * up[i];
                    w[2 * n] = cvt_pk_bf16(h[0], h[1]); w[2 * n + 1] = cvt_pk_bf16(h[2], h[3]); }
                u32x4 wv; wv.x = w[0]; wv.y = w[1]; wv.z = w[2]; wv.w = w[3];
                if (var == 2) asm volatile("" :: "v"(wv)); else EPI_STORE16(H + (size_t)row * DFF + col0, wv); }
    }
};
template <class Epi, class Sched, bool ALIGN_EPI = false, bool SP2 = false>
__device__ __forceinline__ void gemm_phase(PG8_LAS unsigned char* lds, const Gemm g, const Sched& S, const Epi& E, const int wave_id) {
    const int tid_ = wave_id * 64 + mk_lane();
    const int tid = tid_, wid = __builtin_amdgcn_readfirstlane(tid >> 6), lane = tid & 63, wr = wid >> 2, wc = wid & 3, fr = lane & 15, fq = lane >> 4;
    const int K = g.K, nt = K / BK;
    unsigned voffA[2], voffB[2];
#pragma unroll
    for (int i = 0; i < 2; ++i) { int R, C; stage_rc(tid * 16 + i * 8192, R, C); const int Rb = Epi::PERM ? ((R & ~31) + perm32(R & 31)) : R;
        voffA[i] = (unsigned)(R * K + C) * 2u; voffB[i] = (unsigned)(Rb * K + C) * 2u; }
    const size_t kstep = (size_t)(BK * 2);
    const size_t hstep = (size_t)HALF * K * 2;
    const size_t tstep = 2 * hstep;
    const unsigned ldsw = (unsigned)wid * 1024u;
    const int aoff = lds_byte(wr * 64 + fr, fq * 8), boff = lds_byte(wc * 32 + fr, fq * 8);
#define PG8_SA(b, h) (((b) * 2 + (h)) * HTB)
#define PG8_SB(b, h) ((4 + (b) * 2 + (h)) * HTB)
#define PG8_STAGE(bufoff, gbase, voff) do { _Pragma("unroll") for (int _i = 0; _i < 2; ++_i) \
        __builtin_amdgcn_global_load_lds((const unsigned*)((const char*)(gbase) + (voff)[_i]), (PG8_LAS unsigned*)(lds + (bufoff) + ldsw + _i * 8192), 16, 0, 0); } while (0)
#define PG8_LDA(dst, b, h) do { _Pragma("unroll") for (int m = 0; m < 4; ++m) _Pragma("unroll") for (int k = 0; k < 2; ++k) dst[m][k] = *(const PG8_LAS bf16x8*)(lds + PG8_SA(b, h) + aoff + m * 2048 + k * 1024); } while (0)
#define PG8_LDB(dst, b, h) do { _Pragma("unroll") for (int n = 0; n < 2; ++n) _Pragma("unroll") for (int k = 0; k < 2; ++k) dst[n][k] = *(const PG8_LAS bf16x8*)(lds + PG8_SB(b, h) + boff + n * 2048 + k * 1024); } while (0)
#define PG8_MMA(ai, bj, At, Bt) do { __builtin_amdgcn_s_setprio(1); _Pragma("unroll") for (int m = 0; m < 4; ++m) _Pragma("unroll") for (int n = 0; n < 2; ++n) _Pragma("unroll") for (int k = 0; k < 2; ++k) \
        acc[ai][bj][m][n] = __builtin_amdgcn_mfma_f32_16x16x32_bf16(Bt[n][k], At[m][k], acc[ai][bj][m][n], 0, 0, 0); __builtin_amdgcn_s_setprio(0); } while (0)
#define PG8_WAIT_V(n) asm volatile("s_waitcnt vmcnt(" #n ")" ::: "memory")
#define PG8_WAIT_L(n) asm volatile("s_waitcnt lgkmcnt(" #n ")" ::: "memory")
#define PG8_BAR __builtin_amdgcn_s_barrier()
#define PG8_SCHED __builtin_amdgcn_sched_barrier(0)
    Unit cur, nxt; int ui = 0;
    if (!S.next(0, cur)) return;
    f32x4 acc[2][2][4][2];
    float zf = 0.f; asm volatile("" : "+v"(zf));
#pragma unroll
    for (int a = 0; a < 2; ++a)
#pragma unroll
        for (int b = 0; b < 2; ++b)
#pragma unroll
            for (int m = 0; m < 4; ++m)
#pragma unroll
                for (int n = 0; n < 2; ++n) acc[a][b][m][n] = (f32x4){zf, zf, zf, zf};
    bf16x8 At[4][2], B0[2][2], B1[2][2];
    const char* cA = (const char*)g.A + (size_t)cur.pm * tstep; const char* cB = (const char*)g.Bt + (size_t)cur.pn * tstep;
    S.a_ready(cur);
    if constexpr (SP2) {
        PG8_STAGE(PG8_SB(0, 0), cB, voffB); PG8_STAGE(PG8_SB(0, 1), cB + hstep, voffB); PG8_STAGE(PG8_SA(0, 0), cA, voffA); PG8_STAGE(PG8_SA(0, 1), cA + hstep, voffA);
        if (wr == 1) PG8_BAR;
        PG8_WAIT_V(2); PG8_BAR;
        PG8_STAGE(PG8_SB(1, 0), cB + kstep, voffB); PG8_STAGE(PG8_SA(1, 0), cA + kstep, voffA); PG8_STAGE(PG8_SB(1, 1), cB + hstep + kstep, voffB);
        PG8_WAIT_V(6); PG8_BAR;
    } else {
        PG8_STAGE(PG8_SB(0, 0), cB, voffB); PG8_STAGE(PG8_SA(0, 0), cA, voffA); PG8_STAGE(PG8_SB(0, 1), cB + hstep, voffB); PG8_STAGE(PG8_SA(0, 1), cA + hstep, voffA);
        if (wr == 1) PG8_BAR;
        PG8_WAIT_V(4); PG8_BAR;
        PG8_STAGE(PG8_SB(1, 0), cB + kstep, voffB); PG8_STAGE(PG8_SA(1, 0), cA + kstep, voffA); PG8_STAGE(PG8_SB(1, 1), cB + hstep + kstep, voffB);
        PG8_WAIT_V(6); PG8_BAR;
    }
    for (;;) {
        const bool has_next = S.next(ui + 1, nxt);
        const char* nA = has_next ? (const char*)g.A + (size_t)nxt.pm * tstep : cA; const char* nB = has_next ? (const char*)g.Bt + (size_t)nxt.pn * tstep : cB;
#ifdef LOOP_ALIGN
        asm volatile(".p2align " LOOP_ALIGN_STR);
#endif
        for (int t = 0; t < nt; t += 2) {
            const bool last = (t == nt - 2);
            const char* a1 = cA + (size_t)(t + 1) * kstep;
            const char* a2 = last ? nA : cA + (size_t)(t + 2) * kstep; const char* b2 = last ? nB : cB + (size_t)(t + 2) * kstep;
            const char* a3 = a2 + kstep; const char* b3 = b2 + kstep;
            if (last && has_next) S.a_ready(nxt);
            if constexpr (SP2) {
            PG8_LDB(B0, 0, 0); PG8_LDB(B1, 0, 1); PG8_SCHED; PG8_LDA(At, 0, 0); PG8_STAGE(PG8_SA(1, 1), a1 + hstep, voffA);
            PG8_WAIT_V(8); PG8_WAIT_L(0); PG8_BAR; PG8_MMA(0, 0, At, B0); PG8_MMA(0, 1, At, B1); PG8_BAR; PG8_SCHED;
            PG8_LDA(At, 0, 1); PG8_STAGE(PG8_SB(0, 0), b2, voffB); PG8_STAGE(PG8_SB(0, 1), b2 + hstep, voffB); PG8_STAGE(PG8_SA(0, 0), a2, voffA);
            PG8_WAIT_V(8); PG8_WAIT_L(0); PG8_BAR; PG8_MMA(1, 0, At, B0); PG8_MMA(1, 1, At, B1); PG8_BAR; PG8_SCHED;
            PG8_LDB(B0, 1, 0); PG8_LDB(B1, 1, 1); PG8_SCHED; PG8_LDA(At, 1, 0); PG8_STAGE(PG8_SA(0, 1), a2 + hstep, voffA);
            PG8_WAIT_V(8); PG8_WAIT_L(0); PG8_BAR; PG8_MMA(0, 0, At, B0); PG8_MMA(0, 1, At, B1); PG8_BAR; PG8_SCHED;
            PG8_LDA(At, 1, 1); PG8_STAGE(PG8_SB(1, 0), b3, voffB); PG8_STAGE(PG8_SB(1, 1), b3 + hstep, voffB); PG8_STAGE(PG8_SA(1, 0), a3, voffA);
            PG8_WAIT_V(8); PG8_WAIT_L(0); PG8_BAR; PG8_MMA(1, 0, At, B0); PG8_MMA(1, 1, At, B1); PG8_BAR; PG8_SCHED;
            } else {
            PG8_LDB(B0, 0, 0); PG8_SCHED; PG8_LDA(At, 0, 0); PG8_STAGE(PG8_SA(1, 1), a1 + hstep, voffA);
            PG8_WAIT_L(8); PG8_BAR; PG8_WAIT_L(0); PG8_MMA(0, 0, At, B0); PG8_BAR; PG8_SCHED;
            PG8_LDB(B1, 0, 1); PG8_STAGE(PG8_SB(0, 0), b2, voffB);
            PG8_BAR; PG8_WAIT_L(0); PG8_MMA(0, 1, At, B1); PG8_BAR;
            PG8_LDA(At, 0, 1); PG8_STAGE(PG8_SA(0, 0), a2, voffA);
            PG8_BAR; PG8_WAIT_L(0); PG8_MMA(1, 0, At, B0); PG8_BAR; PG8_SCHED;
            PG8_STAGE(PG8_SB(0, 1), b2 + hstep, voffB);
            PG8_WAIT_V(6); PG8_BAR; PG8_MMA(1, 1, At, B1); PG8_BAR;
            PG8_LDB(B0, 1, 0); PG8_SCHED; PG8_LDA(At, 1, 0); PG8_STAGE(PG8_SA(0, 1), a2 + hstep, voffA);
            PG8_WAIT_L(8); PG8_BAR; PG8_WAIT_L(0); PG8_MMA(0, 0, At, B0); PG8_BAR; PG8_SCHED;
            PG8_LDB(B1, 1, 1); PG8_STAGE(PG8_SB(1, 0), b3, voffB);
            PG8_BAR; PG8_WAIT_L(0); PG8_MMA(0, 1, At, B1); PG8_BAR;
            PG8_LDA(At, 1, 1); PG8_STAGE(PG8_SA(1, 0), a3, voffA);
            PG8_BAR; PG8_WAIT_L(0); PG8_MMA(1, 0, At, B0); PG8_BAR; PG8_SCHED;
            PG8_STAGE(PG8_SB(1, 1), b3 + hstep, voffB);
            PG8_WAIT_V(6); PG8_BAR; PG8_MMA(1, 1, At, B1); PG8_BAR;
            }
        }
        if constexpr (ALIGN_EPI) { if (wr == 0) PG8_BAR; }
        if constexpr (!Epi::AFTER_DRAIN) { E(acc, cur, wr, wc, fr, fq); S.done(cur); }
        if (!has_next) break;
        asm volatile("" : "+v"(zf));
#pragma unroll
        for (int a = 0; a < 2; ++a)
#pragma unroll
            for (int b = 0; b < 2; ++b)
#pragma unroll
                for (int m = 0; m < 4; ++m)
#pragma unroll
                    for (int n = 0; n < 2; ++n) acc[a][b][m][n] = (f32x4){zf, zf, zf, zf};
        cur = nxt; cA = nA; cB = nB; ++ui;
        if constexpr (ALIGN_EPI) { if (wr == 1) PG8_BAR; }
    }
    PG8_WAIT_V(0);
    if constexpr (!ALIGN_EPI) { if (wr == 0) PG8_BAR; }
    PG8_BAR;
    if constexpr (Epi::AFTER_DRAIN) { E.fused(acc, cur, wr, wc, fr, fq, lds, wid, lane); S.done(cur); }
#undef PG8_SA
#undef PG8_SB
#undef PG8_STAGE
#undef PG8_LDA
#undef PG8_LDB
#undef PG8_MMA
#undef PG8_WAIT_V
#undef PG8_WAIT_L
#undef PG8_BAR
#undef PG8_SCHED
}
}

#define GAS __attribute__((address_space(1)))
#define LAS __attribute__((address_space(3)))
typedef unsigned short bf16;
typedef unsigned v4u __attribute__((ext_vector_type(4)));
typedef float f32x4 __attribute__((ext_vector_type(4)));
typedef short bf16x8 __attribute__((ext_vector_type(8)));
typedef GAS unsigned gu32;
typedef GAS unsigned long long gu64;
#define RLX_AGENT __ATOMIC_RELAXED, __HIP_MEMORY_SCOPE_AGENT
#define LDS_WAIT() asm volatile("s_waitcnt lgkmcnt(0)" ::: "memory")
#define VM_WAIT() asm volatile("s_waitcnt vmcnt(0)" ::: "memory")
__device__ __forceinline__ unsigned long long rt() { return __builtin_amdgcn_s_memrealtime(); }
__device__ __forceinline__ unsigned f2bf(float f) { unsigned u = __builtin_bit_cast(unsigned, f); return (u + 0x7fffu + ((u >> 16) & 1u)) >> 16; }
__device__ __forceinline__ unsigned pk2(float lo, float hi) { return f2bf(lo) | (f2bf(hi) << 16); }
#define XB_TMO      128
#define XB_XCNT(j)  (256  + 64 * (j))
#define XB_XSUB(j)  (1280 + 64 * (j))
#define XB_XGEN(j)  (2304 + 64 * (j))
#define XB_TOP      3328
#define XB_TOPGEN   3392
#define XB_LSUB(j)  (3456 + 64 * (j))
#define XCD_BAR_WORDS 4480
#define XB_SPIN_CAP (1u << 18)

__device__ __forceinline__ unsigned xb_ld(unsigned* p)              { return __hip_atomic_load(p, __ATOMIC_RELAXED, __HIP_MEMORY_SCOPE_AGENT); }
__device__ __forceinline__ unsigned xb_add(unsigned* p, unsigned v) { return __hip_atomic_fetch_add(p, v, __ATOMIC_RELAXED, __HIP_MEMORY_SCOPE_AGENT); }
__device__ __forceinline__ unsigned xb_xcc_id() { return (unsigned)__builtin_amdgcn_s_getreg((3 << 11) | 20) & 0xFu; }
#define XB_SPIN(cond, bar) do { unsigned _sp = 0; while (cond) { __builtin_amdgcn_s_sleep(1); \
    if ((++_sp & 255u) == 0u) { if (xb_ld(&(bar)[XB_TMO])) break; if (_sp > XB_SPIN_CAP) { atomicAdd(&(bar)[XB_TMO], 1u); break; } } } } while (0)

struct XcdBarrier {
    unsigned* bar; unsigned x;
    volatile LAS unsigned* st;
};

__device__ __forceinline__ XcdBarrier xcd_barrier_post(unsigned* bar, volatile LAS unsigned* st) {
    XcdBarrier b; b.bar = bar; b.x = xb_xcc_id(); b.st = st;
    if (threadIdx.x == 0) st[3] = xb_add(&bar[XB_XCNT(b.x)], 1u);
    return b;
}
__device__ __forceinline__ unsigned xcd_barrier_complete(unsigned* bar, unsigned x, unsigned& nloc, unsigned& nx) {
    const unsigned G = gridDim.x * gridDim.y * gridDim.z;
    unsigned sum, cnt, mine, sp = 0u;
    for (;;) {
        sum = 0u; cnt = 0u; mine = 0u;
#pragma unroll
        for (unsigned j = 0; j < 16; ++j) { const unsigned c = xb_ld(&bar[XB_XCNT(j)]); sum += c; cnt += (c > 0u) ? 1u : 0u; mine = (j == x) ? c : mine; }
        if (sum == G) break;
        __builtin_amdgcn_s_sleep(1);
        if ((++sp & 255u) == 0u) { if (xb_ld(&bar[XB_TMO])) break; if (sp > XB_SPIN_CAP) { atomicAdd(&bar[XB_TMO], 1u); break; } }
    }
    nloc = mine > 0u ? mine : 1u; nx = cnt > 0u ? cnt : 1u;
    return sum;
}

__device__ __forceinline__ void xcd_barrier(const XcdBarrier& b) {
    asm volatile("s_waitcnt vmcnt(0)" ::: "memory");
    __syncthreads();
    if (threadIdx.x == 0) {
        unsigned* bar = b.bar;
        __builtin_amdgcn_s_waitcnt(0);
        unsigned nloc = b.st[0], nx = b.st[1];
        if (nloc == 0u) { const unsigned sum = xcd_barrier_complete(bar, b.x, nloc, nx); b.st[0] = nloc; b.st[1] = nx;
            const unsigned G = gridDim.x * gridDim.y * gridDim.z; bool uni = (sum == G) && (G % 8u == 0u) && nx == 8u;
#pragma unroll
            for (unsigned j = 0; j < 8; ++j) uni = uni && (xb_ld(&bar[XB_XCNT(j)]) == G / 8u);
            b.st[2] = uni ? 2u : 1u; }
        const unsigned old = xb_add(&bar[XB_XSUB(b.x)], 1u);
        const unsigned gen = old / nloc;
        if (old + 1u == (gen + 1u) * nloc) {
            __builtin_amdgcn_fence(__ATOMIC_RELEASE, "agent");
            asm volatile("s_waitcnt vmcnt(0)" ::: "memory");
            const unsigned og = xb_add(&bar[XB_TOP], 1u);
            const unsigned tg = og / nx;
            if (og + 1u == (tg + 1u) * nx) xb_add(&bar[XB_TOPGEN], 1u);
            else XB_SPIN(xb_ld(&bar[XB_TOPGEN]) == tg, bar);
            __builtin_amdgcn_fence(__ATOMIC_ACQUIRE, "agent");
            xb_add(&bar[XB_XGEN(b.x)], 1u);
            asm volatile("s_waitcnt vmcnt(0)" ::: "memory");
        } else {
            XB_SPIN(xb_ld(&bar[XB_XGEN(b.x)]) == gen, bar);
            __builtin_amdgcn_fence(__ATOMIC_ACQUIRE, "agent");
            asm volatile("s_waitcnt vmcnt(0)" ::: "memory");
        }
    }
    __syncthreads();
}

__device__ __forceinline__ void xcd_barrier_local(const XcdBarrier& b) {
    asm volatile("s_waitcnt vmcnt(0)" ::: "memory");
    __syncthreads();
    if (threadIdx.x == 0) {
        unsigned* bar = b.bar;
        __builtin_amdgcn_s_waitcnt(0);
        const unsigned nloc = b.st[0];
        const unsigned old = xb_add(&bar[XB_LSUB(b.x)], 1u);
        const unsigned target = (old / nloc + 1u) * nloc;
#ifndef XB_EARLY_INV
#define XB_EARLY_INV 1
#endif
        if (XB_EARLY_INV) __builtin_amdgcn_fence(__ATOMIC_ACQUIRE, "agent");
        XB_SPIN(xb_ld(&bar[XB_LSUB(b.x)]) < target, bar);
        if (!XB_EARLY_INV) __builtin_amdgcn_fence(__ATOMIC_ACQUIRE, "agent");
        asm volatile("s_waitcnt vmcnt(0)" ::: "memory");
    }
    __syncthreads();
}

__device__ __forceinline__ void xcd_local_arrive(const XcdBarrier& b) {
    asm volatile("s_waitcnt vmcnt(0)" ::: "memory");
    __syncthreads();
    if (threadIdx.x == 0) {
        unsigned* bar = b.bar;
        __builtin_amdgcn_s_waitcnt(0);
        const unsigned nloc = b.st[0];
        const unsigned old = xb_add(&bar[XB_LSUB(b.x)], 1u);
        b.st[12] = (old / nloc + 1u) * nloc;
    }
}
__device__ __forceinline__ void xcd_local_wait(const XcdBarrier& b) {
    asm volatile("s_waitcnt vmcnt(0)" ::: "memory");
    __syncthreads();
    if (threadIdx.x == 0) {
        unsigned* bar = b.bar;
        const unsigned target = b.st[12];
        XB_SPIN(xb_ld(&bar[XB_LSUB(b.x)]) < target, bar);
        __builtin_amdgcn_fence(__ATOMIC_ACQUIRE, "agent");
        asm volatile("s_waitcnt vmcnt(0)" ::: "memory");
    }
    __syncthreads();
}

__device__ __forceinline__ float bf2f(bf16 v) { return __uint_as_float((unsigned)v << 16); }
__device__ __forceinline__ float wave_sum(float v) {
#pragma unroll
    for (int o = 1; o < 64; o <<= 1) v += __shfl_xor(v, o);
    return v;
}
__device__ __forceinline__ float silu_f(float v) { return v / (1.f + __expf(-v)); }

#include <hip/hip_bf16.h>
#include <cmath>
namespace attn_body {
using bf16=__hip_bfloat16;
using bf16x8=__attribute__((ext_vector_type(8)))short;
using s16x4=__attribute__((ext_vector_type(4)))short;
using f32x16=__attribute__((ext_vector_type(16)))float;
using u32x4=__attribute__((ext_vector_type(4)))unsigned;
constexpr int SEQ=4096,D=64,PQ=512,PKV=128,PO=1024;
constexpr int NW=8,QBLK=32,QB=QBLK*NW,KVBLK=64,NQB=SEQ/QB;
constexpr int ATTN_UNIT_ROWS=QB;
__device__ __forceinline__ int crow(int r,int hi){return (r&3)+8*(r>>2)+4*hi;}
#define SBAR() __builtin_amdgcn_sched_barrier(0)
__device__ __forceinline__ void cmask(f32x16&p0,f32x16&p1,int jb,int qrel,int hi){
  const float NEG=-INFINITY; int kb=64*jb+4*hi;
  #pragma unroll
  for(int r=0;r<16;++r){int kv=kb+(r&3)+8*(r>>2); if(kv>qrel)p0[r]=NEG; if(kv+32>qrel)p1[r]=NEG;}
}

constexpr int NSLOT=3, SLOTB=8192;
constexpr int LDS_K=0, LDS_V=NSLOT*SLOTB, LDS_WS=2*NSLOT*SLOTB, LDS_OST=LDS_WS+NW*64*4, LDS_BYTES=LDS_OST+NW*4096;
constexpr float C2=0.125f*1.4426950408889634f;
__device__ __forceinline__ void glds16(const void*gsrc,unsigned lds_dst){unsigned keep;
  asm volatile("s_mov_b32 %0, m0\n\ts_mov_b32 m0, %2\n\ts_nop 0\n\tglobal_load_lds_dwordx4 %1, off\n\ts_mov_b32 m0, %0":"=&s"(keep):"v"(gsrc),"s"(lds_dst):"memory");}
__device__ __forceinline__ float max3f(float a,float b,float c){float r;asm("v_max3_f32 %0, %1, %2, %3":"=v"(r):"v"(a),"v"(b),"v"(c));return r;}
__device__ __forceinline__ float max2f(float a,float b){float r;asm("v_max_f32_e32 %0, %1, %2":"=v"(r):"v"(a),"v"(b));return r;}
__device__ __forceinline__ float fadd_s(float a,float b){float r;asm("v_add_f32_e32 %0, %1, %2":"=v"(r):"v"(a),"v"(b));return r;}
__device__ __forceinline__ float fsub_s(float a,float b){float r;asm("v_sub_f32_e32 %0, %1, %2":"=v"(r):"v"(a),"v"(b));return r;}
typedef float f32x2_t __attribute__((ext_vector_type(2))); typedef __bf16 bf16x2_t __attribute__((ext_vector_type(2)));
__device__ __forceinline__ unsigned cvtpk_s(float lo,float hi){f32x2_t v={lo,hi};bf16x2_t b=__builtin_convertvector(v,bf16x2_t);return __builtin_bit_cast(unsigned,b);}
#define WAIT_BAR(N) asm volatile("s_waitcnt vmcnt(" #N ") lgkmcnt(0)\n\ts_barrier":::"memory")

__device__ __forceinline__ void qkt(f32x16&p0,f32x16&p1,const char*Kslot,const bf16x8*qr,const f32x16&negm,int r32,int hi){
  const char*kb=Kslot+hi*1024+r32*16;
  #pragma unroll
  for(int d0=0;d0<4;++d0){
    const bf16x8 b0=*reinterpret_cast<const bf16x8*>(kb+d0*2048);
    const bf16x8 b1=*reinterpret_cast<const bf16x8*>(kb+d0*2048+512);
    if(d0==0){p0=__builtin_amdgcn_mfma_f32_32x32x16_bf16(b0,qr[0],negm,0,0,0);p1=__builtin_amdgcn_mfma_f32_32x32x16_bf16(b1,qr[0],negm,0,0,0);}
    else{p0=__builtin_amdgcn_mfma_f32_32x32x16_bf16(b0,qr[d0],p0,0,0,0);p1=__builtin_amdgcn_mfma_f32_32x32x16_bf16(b1,qr[d0],p1,0,0,0);}}
}
typedef __attribute__((address_space(3))) const char* lds_cptr;
typedef short v4i16_t __attribute__((ext_vector_type(4)));
__device__ __forceinline__ void kload8(bf16x8*kf,lds_cptr kp){
  kf[0]=*(const __attribute__((address_space(3))) bf16x8*)(kp);      kf[1]=*(const __attribute__((address_space(3))) bf16x8*)(kp+512);
  kf[2]=*(const __attribute__((address_space(3))) bf16x8*)(kp+2048); kf[3]=*(const __attribute__((address_space(3))) bf16x8*)(kp+2560);
  kf[4]=*(const __attribute__((address_space(3))) bf16x8*)(kp+4096); kf[5]=*(const __attribute__((address_space(3))) bf16x8*)(kp+4608);
  kf[6]=*(const __attribute__((address_space(3))) bf16x8*)(kp+6144); kf[7]=*(const __attribute__((address_space(3))) bf16x8*)(kp+6656);
}
__device__ __forceinline__ void kload2(bf16x8*kf,lds_cptr kp,int j){ kf[2*j]=*(const __attribute__((address_space(3))) bf16x8*)(kp+j*2048); kf[2*j+1]=*(const __attribute__((address_space(3))) bf16x8*)(kp+j*2048+512); }
__device__ __forceinline__ s16x4 vtr(lds_cptr p){ return __builtin_bit_cast(s16x4,__builtin_amdgcn_ds_read_tr16_b64_v4i16((__attribute__((address_space(3))) v4i16_t*)p)); }
__device__ __forceinline__ float rowmax(const f32x16&p0,const f32x16&p1){
  float a=max3f(p0[0],p0[1],p1[0]),b=max3f(p0[2],p0[3],p1[1]);a=max3f(a,p1[2],p1[3]);
  #pragma unroll
  for(int r=4;r<16;r+=4){a=max3f(a,p0[r],p0[r+1]);b=max3f(b,p0[r+2],p0[r+3]);a=max3f(a,p1[r],p1[r+1]);b=max3f(b,p1[r+2],p1[r+3]);}
  const float m=max2f(a,b);
  auto rr=__builtin_amdgcn_permlane32_swap(__float_as_uint(m),__float_as_uint(m),false,false);
  return max2f(__uint_as_float(rr[0]),__uint_as_float(rr[1]));
}
__device__ __forceinline__ void pv(f32x16*o,int vb,bf16x8 pa0,bf16x8 pa1,bf16x8 pa2,bf16x8 pa3){
  #pragma unroll
  for(int d0=0;d0<2;++d0){s16x4 lo[4],hi[4];
    #pragma unroll
    for(int ks=0;ks<4;++ks){
      asm volatile("ds_read_b64_tr_b16 %0,%1 offset:%c2":"=&v"(lo[ks]):"v"(vb),"i"(d0*4096+ks*1024):"memory");
      asm volatile("ds_read_b64_tr_b16 %0,%1 offset:%c2":"=&v"(hi[ks]):"v"(vb),"i"(d0*4096+ks*1024+512):"memory");}
    asm volatile("s_waitcnt lgkmcnt(0)":::"memory");SBAR();
    #define PK(k) (bf16x8){lo[k][0],lo[k][1],lo[k][2],lo[k][3],hi[k][0],hi[k][1],hi[k][2],hi[k][3]}
    o[d0]=__builtin_amdgcn_mfma_f32_32x32x16_bf16(pa0,PK(0),o[d0],0,0,0);
    o[d0]=__builtin_amdgcn_mfma_f32_32x32x16_bf16(pa1,PK(1),o[d0],0,0,0);
    o[d0]=__builtin_amdgcn_mfma_f32_32x32x16_bf16(pa2,PK(2),o[d0],0,0,0);
    o[d0]=__builtin_amdgcn_mfma_f32_32x32x16_bf16(pa3,PK(3),o[d0],0,0,0);
    #undef PK
  }
}

#ifndef ATTN_STORE16
#define ATTN_STORE16(p,v) (*(u32x4*)(p)=(v))
#endif
template<int THRL,int NTT=SEQ/KVBLK> __device__ __forceinline__ void attn_unit(int b,int h,int qb,const bf16*Q,const bf16*__restrict__ K,const bf16*__restrict__ V,bf16*O,char*shm,const int wave_id){
  const int tid_=wave_id*64+mk_lane();
  const int tid=tid_,lane=tid&63,r32=lane&31,hi=lane>>5; const int wid=__builtin_amdgcn_readfirstlane(tid>>6);
  const long rowbase=(long)b*SEQ; const int q0=qb*QB;
  const bf16*Qw=Q+(rowbase+q0+wid*QBLK)*PQ+h*D;
  const bf16*Kh=K+rowbase*PKV+(h>>2)*D,*Vh=V+rowbase*PKV+(h>>2)*D;
  const unsigned lds0=(unsigned)(uintptr_t)shm;
  float*wsf=(float*)(shm+LDS_WS)+wid*64;
  const bf16*ksrc=Kh+(long)lane*PKV+wid*8;
  const bf16*vsrc=Vh+(long)(16*(wid&3)+(lane>>2))*PKV+(wid>>2)*32+(lane&3)*8;
  const unsigned kdst=lds0+LDS_K+wid*1024, vdst=lds0+LDS_V+wid*1024;
  #define DMA_K(t,slot) glds16(ksrc+(long)(t)*KVBLK*PKV,(unsigned)__builtin_amdgcn_readfirstlane(kdst+(slot)))
  #define DMA_V(t,slot) glds16(vsrc+(long)(t)*KVBLK*PKV,(unsigned)__builtin_amdgcn_readfirstlane(vdst+(slot)))
  const int vb0=(int)(lds0+LDS_V)+((lane>>4)&1)*32+(lane&3)*8+(4*hi+((lane&15)>>2))*64;
  const char*Kbase=shm+LDS_K; bf16x8 kf[8];
  const lds_cptr shm3=(lds_cptr)shm; const lds_cptr kp0=shm3+LDS_K+hi*1024+r32*16; const lds_cptr vp0=shm3+LDS_V+((lane>>4)&1)*32+(lane&3)*8+(4*hi+((lane&15)>>2))*64;
  constexpr int NT=NTT;
  DMA_K(0,0);DMA_V(0,0);DMA_K(1,SLOTB);
  bf16x8 qr[4];
  #pragma unroll
  for(int d0=0;d0<4;++d0)qr[d0]=*reinterpret_cast<const bf16x8*>(&Qw[(long)r32*PQ+d0*16+hi*8]);
  float mhat=0.f,l_reg=0.f;float zf_=0.f;asm volatile("":"+v"(zf_));f32x16 o[2];
  #pragma unroll
  for(int r=0;r<16;++r){o[0][r]=zf_;o[1][r]=zf_;}
  f32x16 negm;
  #pragma unroll
  for(int r=0;r<16;++r)negm[r]=zf_;
  asm volatile("":"+v"(negm));
  const int qrel=wid*QBLK+r32;
  #define CMASK(P0,P1,t) do{}while(0)
  bool resc=false;
  #define START(P0,P1) do{ const float rm=rowmax(P0,P1); resc=false; \
    { const float dl=rm; mhat=fadd_s(mhat,dl); \
      _Pragma("unroll") for(int r=0;r<16;++r){P0[r]=fsub_s(P0[r],dl);P1[r]=fsub_s(P1[r],dl);} \
      _Pragma("unroll") for(int r=0;r<16;++r)negm[r]=-mhat; asm volatile("":"+v"(negm)); } \
    _Pragma("unroll") for(int r=0;r<16;++r)P0[r]=__builtin_amdgcn_exp2f(P0[r]); }while(0)
  #define RESC() do{ if(resc){ asm volatile("s_waitcnt lgkmcnt(0)":::"memory"); \
      _Pragma("unroll") for(int d_=0;d_<2;++d_) _Pragma("unroll") for(int r=0;r<16;++r)o[d_][r]*=wsf[crow(r,hi)]; } }while(0)
  f32x16 pA0,pA1,pB0,pB1;
  int sl_prev=0,sl_cur=0,sl_next=SLOTB;
  #define ROT() do{sl_prev=sl_cur;sl_cur=sl_next;sl_next=(sl_next==(NSLOT-1)*SLOTB)?0:sl_next+SLOTB;}while(0)
  DMA_K(2,2*SLOTB);
  WAIT_BAR(3);
  qkt(pA0,pA1,Kbase,qr,negm,r32,hi);asm volatile("s_nop 15\n\ts_nop 7":"+v"(pA0),"+v"(pA1));CMASK(pA0,pA1,0);
  START(pA0,pA1);
  _Pragma("unroll") for(int r=0;r<16;++r)pA1[r]=__builtin_amdgcn_exp2f(pA1[r]);
  WAIT_BAR(0);
  DMA_K(3,0);DMA_V(1,SLOTB);
  ROT();
  kload8(kf,kp0+sl_cur);
  WAIT_BAR(2);
  s16x4 vlo[8],vhi[8]; u32x4 pw0,pw1,pw2,pw3;
  #define PKW(P,B) cvtpk_s(P[B],P[B+1])
  #define PAF(k) __builtin_bit_cast(bf16x8,pw##k)
  #define VFR(i) (bf16x8){vlo[i][0],vlo[i][1],vlo[i][2],vlo[i][3],vhi[i][0],vhi[i][1],vhi[i][2],vhi[i][3]}
  #define PIN(x) asm volatile("":"+v"(x))
  #define MX3(a,b,c) __builtin_fmaxf(__builtin_fmaxf((a),(b)),(c))
  #define GAPA(MF,A0,A1,A2,A3,W0,W1,PW) do{ MF; sacc+=A0; sacc+=A1; sacc+=A2; sacc+=A3; PIN(sacc); W0; W1; PIN(PW); SBAR(); }while(0)
  #define EX(v) __builtin_amdgcn_exp2f(v)
  #define GAPB(MF,X,B) do{ MF; X[B]=EX(X[B]); X[B+1]=EX(X[B+1]); X[B+2]=EX(X[B+2]); X[B+3]=EX(X[B+3]); PIN(X); SBAR(); }while(0)
  #define VRD(i) do{ vlo[i]=vtr(vp_+(((i)>>2)*4096+((i)&3)*1024)); vhi[i]=vtr(vp_+(((i)>>2)*4096+((i)&3)*1024+512)); }while(0)
  #define KRD(G,j) do{ if(G){ kload2(kf,kp0+sl_next,j); SBAR(); } }while(0)
  #define STEP(C0,C1,P0,P1,t,GK,GV,GL) do{ SBAR(); \
    const lds_cptr vp_=vp0+sl_prev; \
    VRD(0); SBAR(); float sacc=(P0[0]+P0[1]); \
    GAPA(C0=__builtin_amdgcn_mfma_f32_32x32x16_bf16(kf[0],qr[0],negm,0,0,0), P0[2],P0[3],P0[4],P0[5],     pw0[0]=PKW(P0,0), pw0[1]=PKW(P0,2), pw0); \
    VRD(4); SBAR(); GAPA(C1=__builtin_amdgcn_mfma_f32_32x32x16_bf16(kf[1],qr[0],negm,0,0,0), P0[6],P0[7],P0[8],P0[9],     pw0[2]=PKW(P0,4), pw0[3]=PKW(P0,6), pw0); \
    VRD(1); SBAR(); GAPA(C0=__builtin_amdgcn_mfma_f32_32x32x16_bf16(kf[2],qr[1],C0,0,0,0),   P0[10],P0[11],P0[12],P0[13], pw1[0]=PKW(P0,8), pw1[1]=PKW(P0,10), pw1); \
    VRD(5); SBAR(); GAPA(C1=__builtin_amdgcn_mfma_f32_32x32x16_bf16(kf[3],qr[1],C1,0,0,0),   P0[14],P0[15],P1[0],P1[1],   pw1[2]=PKW(P0,12),pw1[3]=PKW(P0,14), pw1); \
    VRD(2); SBAR(); GAPA(C0=__builtin_amdgcn_mfma_f32_32x32x16_bf16(kf[4],qr[2],C0,0,0,0),   P1[2],P1[3],P1[4],P1[5],     pw2[0]=PKW(P1,0), pw2[1]=PKW(P1,2), pw2); \
    VRD(6); SBAR(); GAPA(C1=__builtin_amdgcn_mfma_f32_32x32x16_bf16(kf[5],qr[2],C1,0,0,0),   P1[6],P1[7],P1[8],P1[9],     pw2[2]=PKW(P1,4), pw2[3]=PKW(P1,6), pw2); \
    VRD(3); SBAR(); GAPA(C0=__builtin_amdgcn_mfma_f32_32x32x16_bf16(kf[6],qr[3],C0,0,0,0),   P1[10],P1[11],P1[12],P1[13], pw3[0]=PKW(P1,8), pw3[1]=PKW(P1,10), pw3); \
    VRD(7); SBAR(); GAPA(C1=__builtin_amdgcn_mfma_f32_32x32x16_bf16(kf[7],qr[3],C1,0,0,0),   P1[14],P1[15],0.f,0.f,       pw3[2]=PKW(P1,12),pw3[3]=PKW(P1,14), pw3); \
    l_reg+=sacc; \
    if(GK){DMA_K((t)+3,sl_cur);} if(GV){DMA_V((t)+1,sl_next);} \
    CMASK(C0,C1,t); \
    { float a=MX3(C0[0],C0[1],C1[0]),b=MX3(C0[2],C0[3],C1[1]); a=MX3(a,C1[2],C1[3]); \
      _Pragma("unroll") for(int r=4;r<16;r+=4){a=MX3(a,C0[r],C0[r+1]);b=MX3(b,C0[r+2],C0[r+3]);a=MX3(a,C1[r],C1[r+1]);b=MX3(b,C1[r+2],C1[r+3]);} \
      float rm=__builtin_fmaxf(a,b); { auto rr=__builtin_amdgcn_permlane32_swap(__float_as_uint(rm),__float_as_uint(rm),false,false); rm=__builtin_fmaxf(__uint_as_float(rr[0]),__uint_as_float(rr[1])); } \
      resc=false; \
      if(__builtin_expect(__any(rm>(float)THRL),0)){ const float dl=__builtin_fmaxf(rm,0.f); mhat+=dl; \
        _Pragma("unroll") for(int r=0;r<16;++r){C0[r]-=dl;C1[r]-=dl;} \
        _Pragma("unroll") for(int r=0;r<16;++r)negm[r]=-mhat; asm volatile("":"+v"(negm)); \
        const float f=__builtin_amdgcn_exp2f(-dl); l_reg*=f; if(hi==0)wsf[r32]=f; resc=true; } } \
    SBAR(); \
    GAPB(o[0]=__builtin_amdgcn_mfma_f32_32x32x16_bf16(PAF(0),VFR(0),o[0],0,0,0), C0,0); \
    GAPB(o[1]=__builtin_amdgcn_mfma_f32_32x32x16_bf16(PAF(0),VFR(4),o[1],0,0,0), C0,4); \
    KRD(GL,0); GAPB(o[0]=__builtin_amdgcn_mfma_f32_32x32x16_bf16(PAF(1),VFR(1),o[0],0,0,0), C0,8); \
    KRD(GL,1); GAPB(o[1]=__builtin_amdgcn_mfma_f32_32x32x16_bf16(PAF(1),VFR(5),o[1],0,0,0), C0,12); \
    KRD(GL,2); GAPB(o[0]=__builtin_amdgcn_mfma_f32_32x32x16_bf16(PAF(2),VFR(2),o[0],0,0,0), C1,0); \
    KRD(GL,3); GAPB(o[1]=__builtin_amdgcn_mfma_f32_32x32x16_bf16(PAF(2),VFR(6),o[1],0,0,0), C1,4); \
    GAPB(o[0]=__builtin_amdgcn_mfma_f32_32x32x16_bf16(PAF(3),VFR(3),o[0],0,0,0), C1,8); \
    GAPB(o[1]=__builtin_amdgcn_mfma_f32_32x32x16_bf16(PAF(3),VFR(7),o[1],0,0,0), C1,12); \
    }while(0)
  int t=1;
  #undef CMASK
  #define CMASK(P0,P1,t) do{}while(0)
#ifdef LOOP_ALIGN
  asm volatile(".p2align " LOOP_ALIGN_STR);
#endif
  for(;t+5<NT;t+=2){
    STEP(pB0,pB1,pA0,pA1,t,true,true,true);     WAIT_BAR(2); RESC(); ROT();
    STEP(pA0,pA1,pB0,pB1,t+1,true,true,true);   WAIT_BAR(2); RESC(); ROT();
  }
  #undef CMASK
  #define CMASK(P0,P1,t) do{}while(0)
  #define ENDW(tt) do{ if((tt)+3<NT){WAIT_BAR(2);} else if((tt)+2<NT){WAIT_BAR(1);} else {WAIT_BAR(0);} }while(0)
  for(;t+1<NT;t+=2){
    STEP(pB0,pB1,pA0,pA1,t,(t+3<NT),(t+1<NT),(t+1<NT));       ENDW(t);   RESC(); ROT();
    STEP(pA0,pA1,pB0,pB1,t+1,(t+4<NT),(t+2<NT),(t+2<NT));     ENDW(t+1); RESC(); ROT();
  }
  STEP(pB0,pB1,pA0,pA1,NT-1,false,false,false); RESC();
  { float sacc=pB0[0]+pB0[1]; _Pragma("unroll") for(int r=2;r<16;++r)sacc+=pB0[r]; _Pragma("unroll") for(int r=0;r<16;++r)sacc+=pB1[r]; l_reg+=sacc;
    pw0=(u32x4){PKW(pB0,0),PKW(pB0,2),PKW(pB0,4),PKW(pB0,6)};pw1=(u32x4){PKW(pB0,8),PKW(pB0,10),PKW(pB0,12),PKW(pB0,14)};pw2=(u32x4){PKW(pB1,0),PKW(pB1,2),PKW(pB1,4),PKW(pB1,6)};pw3=(u32x4){PKW(pB1,8),PKW(pB1,10),PKW(pB1,12),PKW(pB1,14)};
    SBAR(); pv(o,vb0+sl_cur,PAF(0),PAF(1),PAF(2),PAF(3)); }
  #undef PKW
  #undef PAF
  #undef VFR
  #undef PIN
  #undef MX3
  #undef GAPA
  #undef GAPB
  #undef EX
  #undef VRD
  #undef KRD
  #undef STEP
  #undef ENDW
  {auto rr=__builtin_amdgcn_permlane32_swap(__float_as_uint(l_reg),__float_as_uint(l_reg),false,false);l_reg=__uint_as_float(rr[0])+__uint_as_float(rr[1]);}
  if(hi==0)wsf[32+r32]=l_reg;asm volatile("s_waitcnt lgkmcnt(0)":::"memory");
  float rli[16];
  #pragma unroll
  for(int r=0;r<16;++r)rli[r]=__builtin_amdgcn_rcpf(wsf[32+crow(r,hi)]);
  bf16*Ow=O+(rowbase+q0+wid*QBLK)*PO+h*D;
  { bf16*stg=(bf16*)(shm+LDS_OST)+wid*2048;
    #pragma unroll
    for(int r=0;r<16;++r){const int orow=crow(r,hi);
      #pragma unroll
      for(int d0=0;d0<2;++d0)stg[orow*64+d0*32+r32]=__float2bfloat16(o[d0][r]*rli[r]);}
    asm volatile("s_waitcnt lgkmcnt(0)":::"memory");
    #pragma unroll
    for(int i=0;i<4;++i){const int row=i*8+(lane>>3),ch=lane&7; const u32x4 v=*(const u32x4*)(stg+row*64+ch*8); ATTN_STORE16(Ow+(long)row*PO+ch*8,v);} }
  asm volatile("s_waitcnt lgkmcnt(0)\n\ts_barrier":::"memory");
  #undef DMA_K
  #undef DMA_V
  #undef CMASK
  #undef START
  #undef RESC
  #undef ROT
}
constexpr int ATTN_LDS_BYTES=LDS_BYTES;
struct AttnTensors { const bf16* Q; const bf16* K; const bf16* V; bf16* O; };
#undef SBAR
#undef WAIT_BAR
}
namespace ssd {
typedef float f32x16 __attribute__((ext_vector_type(16)));
typedef short v4i16_t __attribute__((ext_vector_type(4)));
typedef unsigned u32x2 __attribute__((ext_vector_type(2)));
typedef LAS unsigned char* lptr;
constexpr int XBLK = 8192 + 64;
constexpr int KCH = 2048 + 16;
constexpr int L_X = 0;
constexpr int L_B = L_X + 8 * XBLK;
constexpr int L_C = L_B + 16 * KCH;
constexpr int L_SC = L_C + 16 * KCH;
constexpr int L_W = L_SC + 8192;
constexpr int L_END = L_W + 4096;
static_assert(4 * XBLK == 16 * KCH, "B region holds either image");
__device__ __forceinline__ int crow(int r, int hi) { return (r & 3) + 8 * (r >> 2) + 4 * hi; }
__device__ __forceinline__ v4i16_t vtr(lptr p) { return __builtin_amdgcn_ds_read_tr16_b64_v4i16((LAS v4i16_t*)p); }
typedef float f32x2_t __attribute__((ext_vector_type(2))); typedef __bf16 bf16x2_t __attribute__((ext_vector_type(2)));
__device__ __forceinline__ unsigned cvtpk(float lo, float hi) { const f32x2_t v = {lo, hi}; return __builtin_bit_cast(unsigned, __builtin_convertvector(v, bf16x2_t)); }
__device__ __forceinline__ float bfl(unsigned v) { return __uint_as_float(v << 16); }
__device__ __forceinline__ float bfh(unsigned v) { return __uint_as_float(v & 0xffff0000u); }
__device__ __forceinline__ f32x16 zero16() { float z = 0.f; asm volatile("" : "+v"(z)); f32x16 r;
#pragma unroll
    for (int i = 0; i < 16; ++i) r[i] = z;
    return r; }
__device__ __forceinline__ float silu(float v) { return v * __builtin_amdgcn_rcpf(1.0f + __builtin_amdgcn_exp2f(-1.4426950408889634f * v)); }

template <bool S3>
__device__ __forceinline__ void conv_stage(lptr lds, const bf16* __restrict__ XR, const float* __restrict__ cw, const float* __restrict__ cb, int b, int c, int g, int tid) {
    const int tq = tid >> 7, cq = tid & 127;
    if (S3 || cq < 96) {
        int col; unsigned dst; int rs;
        if (cq < 64) { col = g * 256 + 4 * cq; dst = L_X + (cq >> 3) * XBLK + (cq & 7) * 8; rs = 64; }
        else { const int q = (cq - 64) & 31; col = (cq < 96 ? 512 : 768) + g * 128 + 4 * q;
            if (S3) { dst = (cq < 96 ? L_B : L_C) + (q >> 1) * KCH + (q & 1) * 8; rs = 16; } else { dst = L_B + (q >> 3) * XBLK + (q & 7) * 8; rs = 64; } }
        dst += (unsigned)(tq * 32 * rs);
        f32x4 w[5];
#pragma unroll
        for (int j = 0; j < 5; ++j) w[j] = *(const f32x4*)(cw + j * NCONV + col);
        const f32x4 bias = *(const f32x4*)(cb + col);
        const int t0 = c * 128 + tq * 32 - 2;
        const bf16* src = XR + ((size_t)b * SEQ) * NCONV + col;
#ifndef OPT_CONV1
#define OPT_CONV1 0
#endif
#if OPT_CONV1
        u32x2 in[36];
#pragma unroll
        for (int i = 0; i < 36; ++i) { const int tt = t0 + i; const bool ok = tt >= 0 && tt < SEQ; const int tc = tt < 0 ? 0 : (tt >= SEQ ? SEQ - 1 : tt);
            const u32x2 v = *(const u32x2*)(src + (size_t)tc * NCONV); in[i].x = ok ? v.x : 0u; in[i].y = ok ? v.y : 0u; }
#pragma unroll
        for (int o = 0; o < 32; ++o) {
            f32x4 a = bias;
#pragma unroll
            for (int j = 0; j < 5; ++j) { const u32x2 v = in[o + j]; a += w[j] * (f32x4){bfl(v.x), bfh(v.x), bfl(v.y), bfh(v.y)}; }
            u32x2 pk; pk.x = cvtpk(silu(a[0]), silu(a[1])); pk.y = cvtpk(silu(a[2]), silu(a[3]));
            *(LAS u32x2*)(lds + dst + (unsigned)(o * rs)) = pk;
        }
#else
#pragma unroll
        for (int hf = 0; hf < 2; ++hf) {
            u32x2 in[20];
#pragma unroll
            for (int i = 0; i < 20; ++i) { const int tt = t0 + hf * 16 + i; const int tc = tt < 0 ? 0 : (tt >= SEQ ? SEQ - 1 : tt);
                in[i] = *(const u32x2*)(src + (size_t)tc * NCONV); }
            __builtin_amdgcn_sched_barrier(0);
#pragma unroll
            for (int i = 0; i < 20; ++i) { const int tt = t0 + hf * 16 + i; const bool ok = tt >= 0 && tt < SEQ; in[i].x = ok ? in[i].x : 0u; in[i].y = ok ? in[i].y : 0u; }
#pragma unroll
            for (int o = 0; o < 16; ++o) {
                f32x4 a = bias;
#pragma unroll
                for (int j = 0; j < 5; ++j) { const u32x2 v = in[o + j]; a += w[j] * (f32x4){bfl(v.x), bfh(v.x), bfl(v.y), bfh(v.y)}; }
                u32x2 pk; pk.x = cvtpk(silu(a[0]), silu(a[1])); pk.y = cvtpk(silu(a[2]), silu(a[3]));
                *(LAS u32x2*)(lds + dst + (unsigned)((hf * 16 + o) * rs)) = pk;
            }
        }
#endif
    }
}
template <bool S1>
__device__ __forceinline__ void scalar_stage(lptr lds, const float* __restrict__ DT, const float* __restrict__ dt_bias, const float* __restrict__ a_log, float* __restrict__ CD, int b, int c, int g, int wid, int lane) {
    const int hd = wid >> 1, dir = wid & 1, hg = 4 * g + hd;
    const float bias = dt_bias[dir * 8 + hg], av = -__expf(a_log[dir * 8 + hg]);
    const size_t m0 = (size_t)b * SEQ + c * 128 + 2 * lane;
    const float v0 = DT[m0 * 16 + dir * 8 + hg] + bias, v1 = DT[(m0 + 1) * 16 + dir * 8 + hg] + bias;
    const float d0 = fmaxf(v0, 0.f) + log1pf(__expf(-fabsf(v0))), d1 = fmaxf(v1, 0.f) + log1pf(__expf(-fabsf(v1)));
    const float l0 = d0 * av, l1 = d1 * av, pair = l0 + l1;
    float incl = pair;
#pragma unroll
    for (int o = 1; o < 64; o <<= 1) { const float t = __shfl_up(incl, o); if (lane >= o) incl += t; }
    const float total = __shfl(incl, 63);
    float a0, a1;
    if (dir == 0) { a0 = (incl - pair) + l0; a1 = a0 + l1; } else { a1 = (total - incl) + l1; a0 = a1 + l0; }
    LAS float* sc = (LAS float*)(lds + L_SC) + (hd * 128 + 2 * lane) * 4;
    sc[dir] = a0; sc[2 + dir] = d0; sc[4 + dir] = a1; sc[6 + dir] = d1;
    if (S1) {
        LAS float* wv = (LAS float*)(lds + L_W) + (hd * 2 + dir) * 128 + 2 * lane;
        wv[0] = d0 * __expf(total - a0); wv[1] = d1 * __expf(total - a1);
        if (lane == 0) CD[((b * 32 + c) * 2 + dir) * 8 + hg] = __expf(total);
    }
}

__device__ __forceinline__ void s1_unit(lptr lds, const bf16* __restrict__ XR, const float* __restrict__ DT, const float* cw, const float* cb, const float* dt_bias, const float* a_log,
                                        bf16* __restrict__ ST, float* __restrict__ CD, int b, int c, int g, const int wave_id) {
    const int tid_ = wave_id * 64 + mk_lane();
    const int tid = tid_, lane = tid & 63, wid = __builtin_amdgcn_readfirstlane(tid >> 6), r = lane & 31, h = lane >> 5;
#ifndef OPT_C
#define OPT_C 0
#endif
    if (OPT_C) scalar_stage<true>(lds, DT, dt_bias, a_log, CD, b, c, g, wid, lane);
    conv_stage<false>(lds, XR, cw, cb, b, c, g, tid);
    if (!OPT_C) scalar_stage<true>(lds, DT, dt_bias, a_log, CD, b, c, g, wid, lane);
    __syncthreads();
    const int hd = wid >> 1, dir = wid & 1, hg = 4 * g + hd;
    const unsigned trb = (unsigned)(((lane >> 4) & 1) * 32 + (lane & 3) * 8 + (4 * h + ((lane & 15) >> 2)) * 64);
    f32x16 acc[2][4];
#pragma unroll
    for (int pt = 0; pt < 2; ++pt)
#pragma unroll
        for (int nt = 0; nt < 4; ++nt) acc[pt][nt] = zero16();
#pragma unroll 2
    for (int k = 0; k < 8; ++k) {
        const LAS f32x4* wp = (const LAS f32x4*)(lds + L_W + ((hd * 2 + dir) * 128 + 16 * k + 4 * h) * 4);
        const f32x4 w0 = wp[0], w1 = wp[2];
        bf16x8 af[2], bfr[4];
#pragma unroll
        for (int pt = 0; pt < 2; ++pt) { const lptr p = lds + L_X + (hd * 2 + pt) * XBLK + trb + k * 1024; const v4i16_t lo = vtr(p), hi = vtr(p + 512);
            unsigned o[4];
            o[0] = cvtpk(bfl((unsigned short)lo[0]) * w0[0], bfl((unsigned short)lo[1]) * w0[1]); o[1] = cvtpk(bfl((unsigned short)lo[2]) * w0[2], bfl((unsigned short)lo[3]) * w0[3]);
            o[2] = cvtpk(bfl((unsigned short)hi[0]) * w1[0], bfl((unsigned short)hi[1]) * w1[1]); o[3] = cvtpk(bfl((unsigned short)hi[2]) * w1[2], bfl((unsigned short)hi[3]) * w1[3]);
            af[pt] = __builtin_bit_cast(bf16x8, (v4u){o[0], o[1], o[2], o[3]}); }
#pragma unroll
        for (int nt = 0; nt < 4; ++nt) { const lptr p = lds + L_B + nt * XBLK + trb + k * 1024; const v4i16_t lo = vtr(p), hi = vtr(p + 512);
            bfr[nt] = (bf16x8){lo[0], lo[1], lo[2], lo[3], hi[0], hi[1], hi[2], hi[3]}; }
#pragma unroll
        for (int pt = 0; pt < 2; ++pt)
#pragma unroll
            for (int nt = 0; nt < 4; ++nt) acc[pt][nt] = __builtin_amdgcn_mfma_f32_32x32x16_bf16(bfr[nt], af[pt], acc[pt][nt], 0, 0, 0);
    }
    bf16* dp = ST + (size_t)(((b * 32 + c) * 2 + dir) * 8 + hg) * 8192 + r * 128 + 4 * h;
#pragma unroll
    for (int pt = 0; pt < 2; ++pt)
#pragma unroll
        for (int nt = 0; nt < 4; ++nt)
#pragma unroll
            for (int q = 0; q < 4; ++q) { u32x2 o; o.x = cvtpk(acc[pt][nt][4 * q], acc[pt][nt][4 * q + 1]); o.y = cvtpk(acc[pt][nt][4 * q + 2], acc[pt][nt][4 * q + 3]);
                *(u32x2*)(dp + pt * 32 * 128 + 32 * nt + 8 * q) = o; }
    __syncthreads();
}

__device__ __forceinline__ void s2_scan(bf16* __restrict__ ST, const float* __restrict__ CD, int first, int stride, const size_t badj = 0) {
    for (int gid = first; gid < BATCH * 2 * 8 * 64 * 16; gid += stride) {
#ifndef SSD_SPLIT
#define SSD_SPLIT 1
#endif
#if SSD_SPLIT
        const int p = gid & 63, n8 = (gid >> 6) & 15, hg = (gid >> 10) & 7, dir = (gid >> 13) & 1, b = gid >> 14; const int eoff = (n8 * 64 + p) * 8;
#else
        const int n8 = gid & 15, p = (gid >> 4) & 63, hg = (gid >> 10) & 7, dir = (gid >> 13) & 1, b = gid >> 14; const int eoff = p * 128 + n8 * 8;
#endif
        const int c0 = dir ? 31 : 0; const long cstep = dir ? -(long)(2 * 8 * 8192) : (long)(2 * 8 * 8192);
        bf16* sp = ST + (size_t)b * badj + (size_t)(((b * 32 + c0) * 2 + dir) * 8 + hg) * 8192 + eoff;
        const float* cp = CD + ((b * 32 + c0) * 2 + dir) * 8 + hg; const int cdstep = dir ? -16 : 16;
        float run[8]; float zf = 0.f; asm volatile("" : "+v"(zf));
#pragma unroll
        for (int k = 0; k < 8; ++k) run[k] = zf;
#ifndef S2_BATCH
#define S2_BATCH 8
#endif
#pragma unroll 1
        for (int cb = 0; cb < 32 / S2_BATCH; ++cb) {
            v4u v[S2_BATCH]; float cd[S2_BATCH];
#pragma unroll
            for (int i = 0; i < S2_BATCH; ++i) { v[i] = *(const v4u*)(sp + i * cstep); cd[i] = cp[i * cdstep]; }
            __builtin_amdgcn_sched_barrier(0);
#pragma unroll
            for (int i = 0; i < S2_BATCH; ++i) {
                v4u o; o.x = cvtpk(run[0], run[1]); o.y = cvtpk(run[2], run[3]); o.z = cvtpk(run[4], run[5]); o.w = cvtpk(run[6], run[7]);
                *(v4u*)(sp + i * cstep) = o;
                run[0] = run[0] * cd[i] + bfl(v[i].x); run[1] = run[1] * cd[i] + bfh(v[i].x); run[2] = run[2] * cd[i] + bfl(v[i].y); run[3] = run[3] * cd[i] + bfh(v[i].y);
                run[4] = run[4] * cd[i] + bfl(v[i].z); run[5] = run[5] * cd[i] + bfh(v[i].z); run[6] = run[6] * cd[i] + bfl(v[i].w); run[7] = run[7] * cd[i] + bfh(v[i].w); }
            sp += S2_BATCH * cstep; cp += S2_BATCH * cdstep;
        }
    }
}

__device__ __forceinline__ void s3_unit(lptr lds, const bf16* __restrict__ XR, const float* __restrict__ DT, const bf16* __restrict__ Z, const float* cw, const float* cb, const float* dt_bias, const float* a_log,
                                        const float* __restrict__ dsk, const float* __restrict__ nw, const bf16* __restrict__ ST, bf16* __restrict__ MIX, int b, int c, int g, const int wave_id) {
    const int tid_ = wave_id * 64 + mk_lane();
    const int tid = tid_, lane = tid & 63, wid = __builtin_amdgcn_readfirstlane(tid >> 6), r = lane & 31, h = lane >> 5;
#ifndef REP_S3CONV
#define REP_S3CONV 1
#endif
#ifndef REP_S3OFF
#define REP_S3OFF 1
#endif
#ifndef REP_S3DIAG
#define REP_S3DIAG 1
#endif
    if (OPT_C) scalar_stage<false>(lds, DT, dt_bias, a_log, nullptr, b, c, g, wid, lane);
    for (int rep_ = 0; rep_ < REP_S3CONV; ++rep_) { conv_stage<true>(lds, XR, cw, cb, b, c, g, tid); if (REP_S3CONV > 1) { asm volatile("s_waitcnt vmcnt(0) lgkmcnt(0)" ::: "memory"); __syncthreads(); } }
    if (!OPT_C) scalar_stage<false>(lds, DT, dt_bias, a_log, nullptr, b, c, g, wid, lane);
    __syncthreads();
    const int lb = wid >> 1, hp = wid & 1, l = 32 * lb + r;
    const unsigned trb = (unsigned)(((lane >> 4) & 1) * 32 + (lane & 3) * 8 + (4 * h + ((lane & 15) >> 2)) * 64);
    const lptr cfp = lds + L_C + h * KCH + l * 16;
    const size_t tok = (size_t)b * SEQ + c * 128 + l;
    float ssum = 0.f;
    unsigned yk[2][2][8];
#pragma unroll
    for (int h2 = 0; h2 < 2; ++h2) {
        const int hd = 2 * hp + h2, hg = 4 * g + hd;
        const f32x4 scl = *(const LAS f32x4*)(lds + L_SC + (hd * 128 + l) * 16);
        f32x16 y[2]; y[0] = zero16(); y[1] = zero16();
        const float dskip = dsk[hg];
#ifndef OPT_FLIP
#define OPT_FLIP 0
#endif
        if (OPT_FLIP && ((wid >> 2) & 1)) {
        int lh = l; asm volatile("" : "+v"(lh));
        for (int rep_ = 0; rep_ < REP_S3DIAG; ++rep_)
#pragma unroll
        for (int st = 0; st < 4; ++st) {
            float kd = 1.f; if (REP_S3DIAG > 1) { kd = rep_ ? 0.f : 1.f; asm volatile("" : "+v"(kd)); }
            f32x16 gt = zero16();
#pragma unroll
            for (int ks = 0; ks < 8; ++ks) { const bf16x8 a = *(const LAS bf16x8*)(lds + L_B + (2 * ks + h) * KCH + (32 * st + r) * 16); const bf16x8 cfk = *(const LAS bf16x8*)(cfp + ks * 2 * KCH); gt = __builtin_amdgcn_mfma_f32_32x32x16_bf16(a, cfk, gt, 0, 0, 0); }
            unsigned o[8];
#ifndef OPT_B
#define OPT_B 0
#endif
            if (!OPT_B || st == lb) {
#pragma unroll
                for (int rp = 0; rp < 8; ++rp) { float pw[2];
#pragma unroll
                    for (int e2 = 0; e2 < 2; ++e2) { const int rg = 2 * rp + e2, s = 32 * st + crow(rg, h); const f32x4 scs = *(const LAS f32x4*)(lds + L_SC + (hd * 128 + s) * 16);
                        const int d = s - lh; const bool lt = d < 0;
                        const float arg = lt ? scl[0] - scs[0] : scl[1] - scs[1]; const float coef = lt ? scs[2] : scs[3];
                        float v = gt[rg] * coef * __expf(arg); if (d == 0) v = gt[rg] * (scs[2] + scs[3]) + dskip; pw[e2] = (REP_S3DIAG > 1) ? v * kd : v; }
                    o[rp] = cvtpk(pw[0], pw[1]); }
            } else {
                const bool fw = st < lb; const int ci = fw ? 0 : 1;
                const float ref = *(const LAS float*)(lds + L_SC + (hd * 128 + (fw ? 32 * lb - 1 : 32 * lb + 32)) * 16 + 4 * ci);
                const float al = __expf(scl[ci] - ref) * ((REP_S3DIAG > 1) ? kd : 1.0f);
#pragma unroll
                for (int rp = 0; rp < 8; ++rp) { float pw[2];
#pragma unroll
                    for (int e2 = 0; e2 < 2; ++e2) { const int rg = 2 * rp + e2, s = 32 * st + crow(rg, h); const f32x4 scs = *(const LAS f32x4*)(lds + L_SC + (hd * 128 + s) * 16);
                        pw[e2] = gt[rg] * (scs[2 + ci] * __expf(ref - scs[ci])) * al; }
                    o[rp] = cvtpk(pw[0], pw[1]); }
            }
            const bf16x8 pf0 = __builtin_bit_cast(bf16x8, (v4u){o[0], o[1], o[2], o[3]}), pf1 = __builtin_bit_cast(bf16x8, (v4u){o[4], o[5], o[6], o[7]});
#pragma unroll
            for (int ks2 = 0; ks2 < 2; ++ks2)
#pragma unroll
                for (int pt = 0; pt < 2; ++pt) { const lptr p = lds + L_X + (hd * 2 + pt) * XBLK + trb + (2 * st + ks2) * 1024; const v4i16_t lo = vtr(p), hi = vtr(p + 512);
                    const bf16x8 a = (bf16x8){lo[0], lo[1], lo[2], lo[3], hi[0], hi[1], hi[2], hi[3]};
                    y[pt] = __builtin_amdgcn_mfma_f32_32x32x16_bf16(a, ks2 ? pf1 : pf0, y[pt], 0, 0, 0); }
        }
        for (int rep_ = 0; rep_ < REP_S3OFF; ++rep_)
#pragma unroll
        for (int dir = 0; dir < 2; ++dir) {
            const bf16* sin = ST + (size_t)(((b * 32 + c) * 2 + dir) * 8 + hg) * 8192 + r * 128 + 8 * h;
            f32x16 yo[2]; yo[0] = zero16(); yo[1] = zero16();
#pragma unroll 4
            for (int ks = 0; ks < 8; ++ks) { const bf16x8 cfk = *(const LAS bf16x8*)(cfp + ks * 2 * KCH);
#pragma unroll
                for (int pt = 0; pt < 2; ++pt) { const bf16x8 a = *(const bf16x8*)(sin + pt * 32 * 128 + 16 * ks); yo[pt] = __builtin_amdgcn_mfma_f32_32x32x16_bf16(a, cfk, yo[pt], 0, 0, 0); } }
            float e = __expf(dir ? scl[1] : scl[0]); if (REP_S3OFF > 1) { float kz = rep_ ? 0.f : 1.f; asm volatile("" : "+v"(kz)); e *= kz; }
            y[0] += yo[0] * e; y[1] += yo[1] * e;
        }
        } else {
        for (int rep_ = 0; rep_ < REP_S3OFF; ++rep_)
#pragma unroll
        for (int dir = 0; dir < 2; ++dir) {
            const bf16* sin = ST + (size_t)(((b * 32 + c) * 2 + dir) * 8 + hg) * 8192 + r * 128 + 8 * h;
            f32x16 yo[2]; yo[0] = zero16(); yo[1] = zero16();
#pragma unroll 4
            for (int ks = 0; ks < 8; ++ks) { const bf16x8 cfk = *(const LAS bf16x8*)(cfp + ks * 2 * KCH);
#pragma unroll
                for (int pt = 0; pt < 2; ++pt) { const bf16x8 a = *(const bf16x8*)(sin + pt * 32 * 128 + 16 * ks); yo[pt] = __builtin_amdgcn_mfma_f32_32x32x16_bf16(a, cfk, yo[pt], 0, 0, 0); } }
            float e = __expf(dir ? scl[1] : scl[0]); if (REP_S3OFF > 1) { float kz = rep_ ? 0.f : 1.f; asm volatile("" : "+v"(kz)); e *= kz; }
            y[0] += yo[0] * e; y[1] += yo[1] * e;
        }
        int lh = l; asm volatile("" : "+v"(lh));
        for (int rep_ = 0; rep_ < REP_S3DIAG; ++rep_)
#pragma unroll
        for (int st = 0; st < 4; ++st) {
            float kd = 1.f; if (REP_S3DIAG > 1) { kd = rep_ ? 0.f : 1.f; asm volatile("" : "+v"(kd)); }
            f32x16 gt = zero16();
#pragma unroll
            for (int ks = 0; ks < 8; ++ks) { const bf16x8 a = *(const LAS bf16x8*)(lds + L_B + (2 * ks + h) * KCH + (32 * st + r) * 16); const bf16x8 cfk = *(const LAS bf16x8*)(cfp + ks * 2 * KCH); gt = __builtin_amdgcn_mfma_f32_32x32x16_bf16(a, cfk, gt, 0, 0, 0); }
            unsigned o[8];
#ifndef OPT_B
#define OPT_B 0
#endif
            if (!OPT_B || st == lb) {
#pragma unroll
                for (int rp = 0; rp < 8; ++rp) { float pw[2];
#pragma unroll
                    for (int e2 = 0; e2 < 2; ++e2) { const int rg = 2 * rp + e2, s = 32 * st + crow(rg, h); const f32x4 scs = *(const LAS f32x4*)(lds + L_SC + (hd * 128 + s) * 16);
                        const int d = s - lh; const bool lt = d < 0;
                        const float arg = lt ? scl[0] - scs[0] : scl[1] - scs[1]; const float coef = lt ? scs[2] : scs[3];
                        float v = gt[rg] * coef * __expf(arg); if (d == 0) v = gt[rg] * (scs[2] + scs[3]) + dskip; pw[e2] = (REP_S3DIAG > 1) ? v * kd : v; }
                    o[rp] = cvtpk(pw[0], pw[1]); }
            } else {
                const bool fw = st < lb; const int ci = fw ? 0 : 1;
                const float ref = *(const LAS float*)(lds + L_SC + (hd * 128 + (fw ? 32 * lb - 1 : 32 * lb + 32)) * 16 + 4 * ci);
                const float al = __expf(scl[ci] - ref) * ((REP_S3DIAG > 1) ? kd : 1.0f);
#pragma unroll
                for (int rp = 0; rp < 8; ++rp) { float pw[2];
#pragma unroll
                    for (int e2 = 0; e2 < 2; ++e2) { const int rg = 2 * rp + e2, s = 32 * st + crow(rg, h); const f32x4 scs = *(const LAS f32x4*)(lds + L_SC + (hd * 128 + s) * 16);
                        pw[e2] = gt[rg] * (scs[2 + ci] * __expf(ref - scs[ci])) * al; }
                    o[rp] = cvtpk(pw[0], pw[1]); }
            }
            const bf16x8 pf0 = __builtin_bit_cast(bf16x8, (v4u){o[0], o[1], o[2], o[3]}), pf1 = __builtin_bit_cast(bf16x8, (v4u){o[4], o[5], o[6], o[7]});
#pragma unroll
            for (int ks2 = 0; ks2 < 2; ++ks2)
#pragma unroll
                for (int pt = 0; pt < 2; ++pt) { const lptr p = lds + L_X + (hd * 2 + pt) * XBLK + trb + (2 * st + ks2) * 1024; const v4i16_t lo = vtr(p), hi = vtr(p + 512);
                    const bf16x8 a = (bf16x8){lo[0], lo[1], lo[2], lo[3], hi[0], hi[1], hi[2], hi[3]};
                    y[pt] = __builtin_amdgcn_mfma_f32_32x32x16_bf16(a, ks2 ? pf1 : pf0, y[pt], 0, 0, 0); }
        }
        }
        const bf16* zp = Z + tok * NSSD + g * 256 + hd * 64 + 4 * h;
#pragma unroll
        for (int pt = 0; pt < 2; ++pt)
#pragma unroll
            for (int q = 0; q < 4; ++q) { const u32x2 zv = *(const u32x2*)(zp + 32 * pt + 8 * q); const float z4[4] = {bfl(zv.x), bfh(zv.x), bfl(zv.y), bfh(zv.y)}; float yv[4];
#pragma unroll
                for (int i = 0; i < 4; ++i) { yv[i] = y[pt][4 * q + i] * silu(z4[i]); ssum += yv[i] * yv[i]; }
                yk[h2][pt][2 * q] = cvtpk(yv[0], yv[1]); yk[h2][pt][2 * q + 1] = cvtpk(yv[2], yv[3]); }
    }
    ssum += __shfl_xor(ssum, 32);
    LAS float* ssx = (LAS float*)(lds + L_W);
    if (h == 0) ssx[hp * 128 + l] = ssum;
    __syncthreads();
    const float rn = rsqrtf((ssx[l] + ssx[128 + l]) * (1.0f / 256.0f) + EPS);
#pragma unroll
    for (int h2 = 0; h2 < 2; ++h2) { const int hd = 2 * hp + h2; const int ch = g * 256 + hd * 64 + 4 * h; bf16* op = MIX + tok * D_MODEL + 512 + ch;
#pragma unroll
        for (int pt = 0; pt < 2; ++pt)
#pragma unroll
            for (int q = 0; q < 4; ++q) { const f32x4 wv = *(const f32x4*)(nw + ch + 32 * pt + 8 * q); const unsigned a0 = yk[h2][pt][2 * q], a1 = yk[h2][pt][2 * q + 1]; u32x2 o;
                o.x = cvtpk(bfl(a0) * rn * wv[0], bfh(a0) * rn * wv[1]); o.y = cvtpk(bfl(a1) * rn * wv[2], bfh(a1) * rn * wv[3]);
                *(u32x2*)(op + 32 * pt + 8 * q) = o; } }
    __syncthreads();
}
}
namespace ssd {
__device__ __forceinline__ void ssa_unit(lptr lds, const bf16* __restrict__ XR, const float* __restrict__ DT, const float* cw, const float* cb, const float* dt_bias, const float* a_log, const float* __restrict__ dsk,
                                         bf16* __restrict__ ST, float* __restrict__ CD, bf16* __restrict__ YD, bf16* __restrict__ CIMG, float* __restrict__ EX, int b, int c, int g, const int wave_id) {
    const int tid_ = wave_id * 64 + mk_lane();
    const int tid = tid_, lane = tid & 63, wid = __builtin_amdgcn_readfirstlane(tid >> 6), r = lane & 31, h = lane >> 5;
    conv_stage<true>(lds, XR, cw, cb, b, c, g, tid);
    scalar_stage<true>(lds, DT, dt_bias, a_log, CD, b, c, g, wid, lane);
    __syncthreads();
    const size_t tok0 = (size_t)b * SEQ + c * 128;
    { const size_t ubase = (size_t)((b * 32 + c) * 2 + g) * 16384;
#pragma unroll
      for (int j = 0; j < 4; ++j) { const int i = tid + 512 * j, ch8 = i >> 7, t = i & 127; *(v4u*)(CIMG + ubase + (size_t)i * 8) = *(const LAS v4u*)(lds + L_C + ch8 * KCH + t * 16); }
      const int hd = tid >> 7, tt = tid & 127; const f32x4 sc = *(const LAS f32x4*)(lds + L_SC + (hd * 128 + tt) * 16);
      EX[(tok0 + tt) * 16 + 4 * g + hd] = __expf(sc[0]); EX[(tok0 + tt) * 16 + 8 + 4 * g + hd] = __expf(sc[1]); }
    { const int lb = wid >> 1, hp = wid & 1, l = 32 * lb + r;
      const unsigned trb = (unsigned)(((lane >> 4) & 1) * 32 + (lane & 3) * 8 + (4 * h + ((lane & 15) >> 2)) * 64);
#ifndef SSA_RANK1
#define SSA_RANK1 0
#endif
#ifndef REP_SSADIAG
#define REP_SSADIAG 1
#endif
#ifndef REP_SSAST
#define REP_SSAST 1
#endif
      bf16x8 cf[8];
#pragma unroll
      for (int ks = 0; ks < 8; ++ks) cf[ks] = *(const LAS bf16x8*)(lds + L_C + (2 * ks + h) * KCH + l * 16);
      const size_t tok = tok0 + l; (void)tok;
#pragma unroll 1
      for (int h2 = 0; h2 < 2; ++h2) {
        const int hd = 2 * hp + h2, hg = 4 * g + hd;
        const f32x4 scl = *(const LAS f32x4*)(lds + L_SC + (hd * 128 + l) * 16);
        f32x16 y[2];
        const float dskip = dsk[hg];
        for (int rep_ = 0; rep_ < REP_SSADIAG; ++rep_) { y[0] = zero16(); y[1] = zero16();
        { int lh = l; asm volatile("" : "+v"(lh));
#pragma unroll
        for (int st = 0; st < 4; ++st) {
            bf16x8 bfg[8];
#pragma unroll
            for (int ks = 0; ks < 8; ++ks) bfg[ks] = *(const LAS bf16x8*)(lds + L_B + (2 * ks + h) * KCH + (32 * st + r) * 16);
            f32x16 gt = zero16();
#pragma unroll
            for (int ks = 0; ks < 8; ++ks) gt = __builtin_amdgcn_mfma_f32_32x32x16_bf16(bfg[ks], cf[ks], gt, 0, 0, 0);
            unsigned o[8];
            if (!SSA_RANK1 || st == lb) {
#pragma unroll
                for (int rp = 0; rp < 8; ++rp) { float pw[2];
#pragma unroll
                    for (int e2 = 0; e2 < 2; ++e2) { const int rg = 2 * rp + e2, s = 32 * st + crow(rg, h); const f32x4 scs = *(const LAS f32x4*)(lds + L_SC + (hd * 128 + s) * 16);
                        const int d = s - lh; const bool lt = d < 0;
                        const float arg = lt ? scl[0] - scs[0] : scl[1] - scs[1]; const float coef = lt ? scs[2] : scs[3];
                        float v = gt[rg] * coef * __expf(arg); if (d == 0) v = gt[rg] * (scs[2] + scs[3]) + dskip; pw[e2] = v; }
                    o[rp] = cvtpk(pw[0], pw[1]); }
            } else {
                const bool fw = st < lb; const int ci = fw ? 0 : 1;
                const float ref = *(const LAS float*)(lds + L_SC + (hd * 128 + (fw ? 32 * lb - 1 : 32 * lb + 32)) * 16 + 4 * ci);
                const float al = __expf(scl[ci] - ref);
#pragma unroll
                for (int rp = 0; rp < 8; ++rp) { float pw[2];
#pragma unroll
                    for (int e2 = 0; e2 < 2; ++e2) { const int rg = 2 * rp + e2, s = 32 * st + crow(rg, h); const f32x4 scs = *(const LAS f32x4*)(lds + L_SC + (hd * 128 + s) * 16);
                        pw[e2] = gt[rg] * (scs[2 + ci] * __expf(ref - scs[ci])) * al; }
                    o[rp] = cvtpk(pw[0], pw[1]); }
            }
            const bf16x8 pf0 = __builtin_bit_cast(bf16x8, (v4u){o[0], o[1], o[2], o[3]}), pf1 = __builtin_bit_cast(bf16x8, (v4u){o[4], o[5], o[6], o[7]});
            bf16x8 xa[2][2];
#pragma unroll
            for (int ks2 = 0; ks2 < 2; ++ks2)
#pragma unroll
                for (int pt = 0; pt < 2; ++pt) { const lptr p = lds + L_X + (hd * 2 + pt) * XBLK + trb + (2 * st + ks2) * 1024; const v4i16_t lo = vtr(p), hi = vtr(p + 512);
                    xa[ks2][pt] = (bf16x8){lo[0], lo[1], lo[2], lo[3], hi[0], hi[1], hi[2], hi[3]}; }
#pragma unroll
            for (int ks2 = 0; ks2 < 2; ++ks2)
#pragma unroll
                for (int pt = 0; pt < 2; ++pt) y[pt] = __builtin_amdgcn_mfma_f32_32x32x16_bf16(xa[ks2][pt], ks2 ? pf1 : pf0, y[pt], 0, 0, 0);
        } }
        if (REP_SSADIAG > 1) asm volatile("" :: "v"(y[0]), "v"(y[1])); }
        bf16* yp = YD + (size_t)((b * 32 + c) * 2 + g) * 32768 + (size_t)(hd * 8 * 128 + l) * 8 + 4 * h;
#pragma unroll
        for (int pt = 0; pt < 2; ++pt)
#pragma unroll
            for (int q = 0; q < 4; ++q) { u32x2 o; o.x = cvtpk(y[pt][4 * q], y[pt][4 * q + 1]); o.y = cvtpk(y[pt][4 * q + 2], y[pt][4 * q + 3]); *(u32x2*)(yp + (pt * 4 + q) * 1024) = o; }
      } }
    { const int hd = wid >> 1, dir = wid & 1, hg = 4 * g + hd;
      const unsigned trx = (unsigned)(((lane >> 4) & 1) * 32 + (lane & 3) * 8 + (4 * h + ((lane & 15) >> 2)) * 64);
      const unsigned trk = (unsigned)((2 * ((lane >> 4) & 1) + ((lane & 3) >> 1)) * KCH + (4 * h + ((lane & 15) >> 2)) * 16 + (lane & 1) * 8);
      f32x16 acc[2][4];
#pragma unroll
      for (int pt = 0; pt < 2; ++pt)
#pragma unroll
          for (int nt = 0; nt < 4; ++nt) acc[pt][nt] = zero16();
#pragma unroll 2
      for (int k = 0; k < 8; ++k) {
          const LAS f32x4* wp = (const LAS f32x4*)(lds + L_W + ((hd * 2 + dir) * 128 + 16 * k + 4 * h) * 4);
          const f32x4 w0 = wp[0], w1 = wp[2];
          bf16x8 af[2], bfr[4];
#pragma unroll
          for (int pt = 0; pt < 2; ++pt) { const lptr p = lds + L_X + (hd * 2 + pt) * XBLK + trx + k * 1024; const v4i16_t lo = vtr(p), hi = vtr(p + 512);
              unsigned o[4];
              o[0] = cvtpk(bfl((unsigned short)lo[0]) * w0[0], bfl((unsigned short)lo[1]) * w0[1]); o[1] = cvtpk(bfl((unsigned short)lo[2]) * w0[2], bfl((unsigned short)lo[3]) * w0[3]);
              o[2] = cvtpk(bfl((unsigned short)hi[0]) * w1[0], bfl((unsigned short)hi[1]) * w1[1]); o[3] = cvtpk(bfl((unsigned short)hi[2]) * w1[2], bfl((unsigned short)hi[3]) * w1[3]);
              af[pt] = __builtin_bit_cast(bf16x8, (v4u){o[0], o[1], o[2], o[3]}); }
#pragma unroll
          for (int nt = 0; nt < 4; ++nt) { const lptr p = lds + L_B + (4 * nt) * KCH + trk + k * 256; const v4i16_t lo = vtr(p), hi = vtr(p + 128);
              bfr[nt] = (bf16x8){lo[0], lo[1], lo[2], lo[3], hi[0], hi[1], hi[2], hi[3]}; }
#pragma unroll
          for (int pt = 0; pt < 2; ++pt)
#pragma unroll
              for (int nt = 0; nt < 4; ++nt) acc[pt][nt] = __builtin_amdgcn_mfma_f32_32x32x16_bf16(bfr[nt], af[pt], acc[pt][nt], 0, 0, 0);
      }
      bf16* dp = ST + (size_t)(((b * 32 + c) * 2 + dir) * 8 + hg) * 8192 + r * 8 + 4 * h;
#pragma unroll
      for (int pt = 0; pt < 2; ++pt)
#pragma unroll
          for (int nt = 0; nt < 4; ++nt)
#pragma unroll
              for (int q = 0; q < 4; ++q) { u32x2 o; o.x = cvtpk(acc[pt][nt][4 * q], acc[pt][nt][4 * q + 1]); o.y = cvtpk(acc[pt][nt][4 * q + 2], acc[pt][nt][4 * q + 3]);
                  *(u32x2*)(dp + ((4 * nt + q) * 64 + 32 * pt) * 8) = o; } }
    __syncthreads();
}

__device__ __forceinline__ void ssb_unit(lptr lds, const bf16* __restrict__ Z, const float* __restrict__ nw, const bf16* __restrict__ ST, const bf16* __restrict__ YD, const bf16* __restrict__ CIMG, const float* __restrict__ EX,
                                         bf16* __restrict__ MIX, int b, int c, int g, const int wave_id) {
    const int tid_ = wave_id * 64 + mk_lane();
    const int tid = tid_, lane = tid & 63, wid = __builtin_amdgcn_readfirstlane(tid >> 6), r = lane & 31, h = lane >> 5;
    const int lb = wid >> 1, hp = wid & 1, l = 32 * lb + r;
    const size_t tok = (size_t)b * SEQ + c * 128 + l;
    bf16x8 cf[8];
#pragma unroll
    for (int ks = 0; ks < 8; ++ks) cf[ks] = *(const bf16x8*)(CIMG + (size_t)((b * 32 + c) * 2 + g) * 16384 + (size_t)((2 * ks + h) * 128 + l) * 8);
    float ssum = 0.f;
    unsigned yk[2][2][8];
#pragma unroll
    for (int h2 = 0; h2 < 2; ++h2) {
        const int hd = 2 * hp + h2, hg = 4 * g + hd;
        f32x16 y[2]; y[0] = zero16(); y[1] = zero16();
#pragma unroll
        for (int dir = 0; dir < 2; ++dir) {
            const bf16* sin = ST + (size_t)(((b * 32 + c) * 2 + dir) * 8 + hg) * 8192 + (h * 64 + r) * 8;
            f32x16 yo[2]; yo[0] = zero16(); yo[1] = zero16();
            bf16x8 af[8][2];
#pragma unroll
            for (int ks = 0; ks < 8; ++ks)
#pragma unroll
                for (int pt = 0; pt < 2; ++pt) af[ks][pt] = *(const bf16x8*)(sin + (2 * ks * 64 + 32 * pt) * 8);
            const float e = EX[tok * 16 + dir * 8 + hg];
            __builtin_amdgcn_sched_barrier(0);
#pragma unroll
            for (int ks = 0; ks < 8; ++ks)
#pragma unroll
                for (int pt = 0; pt < 2; ++pt) yo[pt] = __builtin_amdgcn_mfma_f32_32x32x16_bf16(af[ks][pt], cf[ks], yo[pt], 0, 0, 0);
            __builtin_amdgcn_sched_barrier(0);
            y[0] += yo[0] * e; y[1] += yo[1] * e;
        }
        const bf16* zp = Z + tok * NSSD + g * 256 + hd * 64 + 4 * h; const bf16* ydp = YD + (size_t)((b * 32 + c) * 2 + g) * 32768 + (size_t)(hd * 8 * 128 + l) * 8 + 4 * h;
        u32x2 zv[2][4], dv[2][4];
#pragma unroll
        for (int pt = 0; pt < 2; ++pt)
#pragma unroll
            for (int q = 0; q < 4; ++q) { zv[pt][q] = *(const u32x2*)(zp + 32 * pt + 8 * q); dv[pt][q] = *(const u32x2*)(ydp + (pt * 4 + q) * 1024); }
        __builtin_amdgcn_sched_barrier(0);
#pragma unroll
        for (int pt = 0; pt < 2; ++pt)
#pragma unroll
            for (int q = 0; q < 4; ++q) { const float z4[4] = {bfl(zv[pt][q].x), bfh(zv[pt][q].x), bfl(zv[pt][q].y), bfh(zv[pt][q].y)}, d4[4] = {bfl(dv[pt][q].x), bfh(dv[pt][q].x), bfl(dv[pt][q].y), bfh(dv[pt][q].y)}; float yv[4];
#pragma unroll
                for (int i = 0; i < 4; ++i) { yv[i] = (y[pt][4 * q + i] + d4[i]) * silu(z4[i]); ssum += yv[i] * yv[i]; }
                yk[h2][pt][2 * q] = cvtpk(yv[0], yv[1]); yk[h2][pt][2 * q + 1] = cvtpk(yv[2], yv[3]); }
    }
    ssum += __shfl_xor(ssum, 32);
    LAS float* ssx = (LAS float*)(lds + L_W);
    if (h == 0) ssx[hp * 128 + l] = ssum;
    __syncthreads();
    const float rn = rsqrtf((ssx[l] + ssx[128 + l]) * (1.0f / 256.0f) + EPS);
#pragma unroll
    for (int h2 = 0; h2 < 2; ++h2) { const int hd = 2 * hp + h2; const int ch = g * 256 + hd * 64 + 4 * h; bf16* op = MIX + tok * D_MODEL + 512 + ch;
#pragma unroll
        for (int pt = 0; pt < 2; ++pt)
#pragma unroll
            for (int q = 0; q < 4; ++q) { const f32x4 wv = *(const f32x4*)(nw + ch + 32 * pt + 8 * q); const unsigned a0 = yk[h2][pt][2 * q], a1 = yk[h2][pt][2 * q + 1]; u32x2 o;
                o.x = cvtpk(bfl(a0) * rn * wv[0], bfh(a0) * rn * wv[1]); o.y = cvtpk(bfl(a1) * rn * wv[2], bfh(a1) * rn * wv[3]);
                *(u32x2*)(op + 32 * pt + 8 * q) = o; } }
    __syncthreads();
}
}

constexpr int NWAVES = 8;
constexpr int RING_OFF = 0, RING_BYTES = 131072;
constexpr int LDS_BYTES = 163840;
constexpr int LDSCTL_OFF = LDS_BYTES - 1024, MISC_OFF = LDSCTL_OFF + 320;
static_assert(ssd::L_END <= LDSCTL_OFF && attn_body::ATTN_LDS_BYTES <= RING_BYTES, "LDS map");
constexpr int TAB_OFF = RING_BYTES;
#ifndef GEMM_ALIGN
#define GEMM_ALIGN true
#endif
#ifndef GEMM_SP2
#define GEMM_SP2 true
#endif
constexpr int NPHASE = 16;
#ifndef REP_P0
#define REP_P0 1
#endif
#ifndef REP_IN
#define REP_IN 1
#endif
#ifndef REP_S1
#define REP_S1 1
#endif
#ifndef REP_ATT
#define REP_ATT 1
#endif
#ifndef REP_S3
#define REP_S3 1
#endif
#ifndef REP_GU
#define REP_GU 1
#endif
#ifndef REP_OUT0
#define REP_OUT0 1
#endif

struct Frame {
    LAS unsigned char* lds; volatile LAS unsigned* MISC;
    int tid, lane, wave, vcu, G;
};
struct Args { const float* in[17]; float* out; unsigned char* ws; int ph_lo, ph_hi; };

struct ConvDesc { const float* W; const float* ks; bf16* WT; int ldw, k0, srcc0, K, drow0; bool perm; };
struct ConvSrc { const float *win, *wout, *wg, *wu, *wd, *n1, *n2; };
__device__ __forceinline__ ConvDesc conv_desc(const ConvSrc& a, unsigned char* ws, int l, int it) {
    constexpr int I_IN = 16 * 72, I_OUT = 16 * 32, I_GU = 16 * 176;
    ConvDesc d; int r = it;
    if (r < I_IN) { const int kb = r / 72, rb = r % 72, pn = pg8::inproj_ltile(rb >> 3), blk = rb & 7, bj = blk >> 2, wc = blk & 3;
        d.perm = pn <= 2; d.srcc0 = d.perm ? ((pn < 2 ? pn * 256 : 512) + wc * 64 + 32 * bj) : (pn * 8 + blk) * 32;
        d.W = a.win + (size_t)l * D_MODEL * NIN; d.ldw = NIN; d.ks = a.n1 + l * D_MODEL; d.k0 = kb * 64; d.WT = (bf16*)(ws + WS_WIN) + (size_t)l * NINM * D_MODEL; d.K = D_MODEL; d.drow0 = rb * 32; return d; }
    r -= I_IN; d.perm = false;
    if (r < I_OUT) { const int kb = r / 32, rb = r % 32;
        d.W = a.wout + (size_t)l * D_MODEL * D_MODEL; d.ldw = D_MODEL; d.ks = nullptr; d.k0 = kb * 64; d.srcc0 = rb * 32; d.WT = (bf16*)(ws + WS_WOUT) + (size_t)l * D_MODEL * D_MODEL; d.K = D_MODEL; d.drow0 = rb * 32; return d; }
    r -= I_OUT;
    if (r < I_GU) { const int kb = r / 176, rb = r % 176, pn = rb >> 3, blk = rb & 7, bj = blk >> 2, wc = blk & 3;
        d.W = (bj ? a.wu : a.wg) + (size_t)l * D_MODEL * DFF; d.ldw = DFF; d.ks = a.n2 + l * D_MODEL; d.k0 = kb * 64; d.srcc0 = pn * 128 + wc * 32; d.WT = (bf16*)(ws + WS_WGU) + (size_t)l * NGU * D_MODEL; d.K = D_MODEL; d.drow0 = rb * 32; return d; }
    r -= I_GU;
    { const int kb = r / 32, rb = r % 32;
        d.W = a.wd + (size_t)l * DFF * D_MODEL; d.ldw = D_MODEL; d.ks = nullptr; d.k0 = kb * 64; d.srcc0 = rb * 32; d.WT = (bf16*)(ws + WS_WDN) + (size_t)l * D_MODEL * DFF; d.K = DFF; d.drow0 = rb * 32; return d; }
}
__device__ __forceinline__ void conv_load(const ConvDesc& d, f32x4 (&v)[8], float (&kv)[8], int lane) {
    const int r8 = lane >> 3, g = lane & 7, sg = d.perm ? (4 * (g & 1) + (g >> 1)) : g;
    const float* p = d.W + (size_t)(d.k0 + r8) * d.ldw + d.srcc0 + 4 * sg;
#pragma unroll
    for (int i = 0; i < 8; ++i) { v[i] = *(const f32x4*)(p + (size_t)(8 * i) * d.ldw); kv[i] = d.ks ? d.ks[d.k0 + 8 * i + r8] : 1.0f; }
}
__device__ __forceinline__ void conv_finish(const ConvDesc& d, const f32x4 (&v)[8], const float (&kv)[8], LAS float* scr, int lane) {
    const int r8 = lane >> 3, g = lane & 7;
#pragma unroll
    for (int i = 0; i < 8; ++i) { LAS float* s = scr + (8 * i + r8) * 33 + 4 * g; const f32x4 w = v[i] * kv[i]; s[0] = w[0]; s[1] = w[1]; s[2] = w[2]; s[3] = w[3]; }
    LDS_WAIT(); asm volatile("" ::: "memory");
    const int c8 = lane & 7;
#pragma unroll
    for (int j = 0; j < 4; ++j) { const int n = (lane >> 3) + 8 * j; const LAS float* s = scr + (8 * c8) * 33 + n;
        v4u o; o.x = pk2(s[0 * 33], s[1 * 33]); o.y = pk2(s[2 * 33], s[3 * 33]); o.z = pk2(s[4 * 33], s[5 * 33]); o.w = pk2(s[6 * 33], s[7 * 33]);
        *(GAS v4u*)(d.WT + (size_t)(d.drow0 + n) * d.K + d.k0 + 8 * c8) = o; }
    LDS_WAIT(); asm volatile("" ::: "memory");
}
__device__ __forceinline__ void convert_layer_weights(Frame& F, const Args& a, int l, int gw, int NGW) {
    unsigned char* ws = a.ws;
    LAS float* scr = (LAS float*)(F.lds + RING_OFF + F.wave * 16384);
    constexpr int I_L = 16 * 72 + 16 * 32 + 16 * 176 + 44 * 32;
    ConvSrc cs{a.in[2], a.in[11], a.in[13], a.in[14], a.in[15], a.in[1], a.in[12]};
    asm volatile("" : "+s"(cs.win), "+s"(cs.wout), "+s"(cs.wg), "+s"(cs.wu), "+s"(cs.wd), "+s"(cs.n1), "+s"(cs.n2));
    for (int it = gw; it < I_L; it += 3 * NGW) {
        const bool h1 = it + NGW < I_L, h2 = it + 2 * NGW < I_L;
        const ConvDesc d0 = conv_desc(cs, ws, l, it), d1 = conv_desc(cs, ws, l, h1 ? it + NGW : it), d2 = conv_desc(cs, ws, l, h2 ? it + 2 * NGW : it);
        f32x4 v0[8], v1[8], v2[8]; float k0[8], k1[8], k2[8];
        conv_load(d0, v0, k0, F.lane); conv_load(d1, v1, k1, F.lane); conv_load(d2, v2, k2, F.lane);
        __builtin_amdgcn_sched_barrier(0);
        conv_finish(d0, v0, k0, scr, F.lane);
        if (h1) conv_finish(d1, v1, k1, scr, F.lane);
        if (h2) conv_finish(d2, v2, k2, scr, F.lane);
    }
}
__device__ __forceinline__ void p0_prologue(Frame& F, const Args& a) {
    unsigned char* ws = a.ws;
    const int gw = F.vcu * NWAVES + F.wave, NGW = F.G * NWAVES;
#ifndef OPT_A
#define OPT_A 0
#endif
#ifndef REP_CONV
#define REP_CONV 1
#endif
    for (int rc_ = 1; rc_ < REP_CONV; ++rc_) { convert_layer_weights(F, a, 0, gw, NGW); asm volatile("s_waitcnt vmcnt(0)" ::: "memory"); }
    convert_layer_weights(F, a, 0, gw, NGW);
    if (!OPT_A) convert_layer_weights(F, a, 1, gw, NGW);
    for (int e = (F.vcu * NWAVES + F.wave) * 64 + F.lane; e < 2 * 16 * D_MODEL; e += NGW * 64) { const int l = e >> 14, j = (e >> 10) & 15, k = e & 1023;
        ((bf16*)(ws + WS_WDT))[e] = (bf16)f2bf(a.in[2][(size_t)l * D_MODEL * NIN + (size_t)k * NIN + NINM + j] * a.in[1][l * D_MODEL + k]); }
    if (blockIdx.x == 0) { float* tab = (float*)(ws + WS_ROPE);
        for (int i = F.tid; i < 1024; i += NWAVES * 64) { const int pos = i >> 4, j = i & 15; const float inv = powf(10000.f, -(2.0f * (float)j) / 32.f); const float ang = (float)pos * inv; tab[i] = cosf(ang); tab[1024 + i] = sinf(ang); } }
    const float* x = a.in[0]; bf16* XN = (bf16*)(ws + WS_XN); float* SSQ = (float*)(ws + WS_SSQ);
    for (int row = gw; row < M; row += NGW) {
        const f32x4* xr = (const f32x4*)(x + (size_t)row * D_MODEL); float s = 0.f; f32x4 v[4];
#pragma unroll
        for (int j = 0; j < 4; ++j) { v[j] = xr[F.lane + 64 * j]; const f32x4 q = v[j] * v[j]; s += (q[0] + q[1]) + (q[2] + q[3]); }
        s = wave_sum(s);
        unsigned long long* o8 = (unsigned long long*)(XN + (size_t)row * D_MODEL) + F.lane;
#pragma unroll
        for (int j = 0; j < 4; ++j) o8[64 * j] = (unsigned long long)pk2(v[j][0], v[j][1]) | ((unsigned long long)pk2(v[j][2], v[j][3]) << 32);
        if (F.lane < 16) SSQ[(size_t)row * 16 + F.lane] = F.lane == 0 ? s : 0.f;
    }
}

#ifndef OPT_DT
#define OPT_DT 2
#endif
#if OPT_DT == 2
__device__ __forceinline__ void dt_units(Frame& F, const bf16* __restrict__ XN, const bf16* __restrict__ Wdt, const float* __restrict__ SSQ, float* __restrict__ DT, const int tbase, const int gw, const int NGW, const int ntask) {
    const int r16 = F.lane & 15, q = F.lane >> 4;
    constexpr int WROW = 2048 + 16;
    for (int i = F.tid; i < 16 * 128; i += NWAVES * 64) { const int j = i >> 7, c = i & 127; *(LAS v4u*)(F.lds + RING_OFF + j * WROW + c * 16) = *(const v4u*)(Wdt + (size_t)j * D_MODEL + c * 8); }
    __syncthreads();
    const LAS unsigned char* bl = F.lds + RING_OFF + r16 * WROW + q * 16;
    for (int t_ = gw; t_ < ntask; t_ += NGW) { const int task = tbase + t_;
        const bf16* ap = XN + (size_t)(task * 16 + r16) * D_MODEL + 8 * q;
        bf16x8 av[32]; f32x4 sq[4][4];
#pragma unroll
        for (int j = 0; j < 32; ++j) av[j] = *(const bf16x8*)(ap + 32 * j);
#pragma unroll
        for (int rg = 0; rg < 4; ++rg) { const f32x4* sp = (const f32x4*)(SSQ + (size_t)(task * 16 + 4 * q + rg) * 16);
#pragma unroll
            for (int j = 0; j < 4; ++j) sq[rg][j] = sp[j]; }
        __builtin_amdgcn_sched_barrier(0);
        float zf = 0.f; asm volatile("" : "+v"(zf)); f32x4 acc = {zf, zf, zf, zf};
#pragma unroll
        for (int j = 0; j < 32; ++j) { const bf16x8 bv = *(const LAS bf16x8*)(bl + j * 64); acc = __builtin_amdgcn_mfma_f32_16x16x32_bf16(av[j], bv, acc, 0, 0, 0); }
#pragma unroll
        for (int rg = 0; rg < 4; ++rg) { const int tok = task * 16 + 4 * q + rg; const f32x4 s0 = sq[rg][0], s1 = sq[rg][1], s2 = sq[rg][2], s3 = sq[rg][3];
            const float s = ((s0[0] + s0[1]) + (s0[2] + s0[3])) + ((s1[0] + s1[1]) + (s1[2] + s1[3])) + ((s2[0] + s2[1]) + (s2[2] + s2[3])) + ((s3[0] + s3[1]) + (s3[2] + s3[3]));
            DT[(size_t)tok * 16 + r16] = acc[rg] * rsqrtf(s * (1.0f / 1024.0f) + EPS); }
    }
    __syncthreads();
}
#elif OPT_DT
__device__ __forceinline__ void dt_units(Frame& F, const bf16* __restrict__ XN, const bf16* __restrict__ Wdt, const float* __restrict__ SSQ, float* __restrict__ DT) {
    const int gw = F.vcu * NWAVES + F.wave, NGW = F.G * NWAVES, r16 = F.lane & 15, q = F.lane >> 4;
    constexpr int WROW = 2048 + 16;
    for (int i = F.tid; i < 16 * 128; i += NWAVES * 64) { const int j = i >> 7, c = i & 127; *(LAS v4u*)(F.lds + RING_OFF + j * WROW + c * 16) = *(const v4u*)(Wdt + (size_t)j * D_MODEL + c * 8); }
    __syncthreads();
    const LAS unsigned char* bl = F.lds + RING_OFF + r16 * WROW + q * 16;
    for (int task = gw; task < M / 16; task += NGW) {
        const bf16* ap = XN + (size_t)(task * 16 + r16) * D_MODEL + 8 * q;
        float zf = 0.f; asm volatile("" : "+v"(zf)); f32x4 acc = {zf, zf, zf, zf};
#pragma unroll 16
        for (int k0 = 0; k0 < D_MODEL; k0 += 32) { const bf16x8 av = *(const bf16x8*)(ap + k0), bv = *(const LAS bf16x8*)(bl + k0 * 2); acc = __builtin_amdgcn_mfma_f32_16x16x32_bf16(av, bv, acc, 0, 0, 0); }
#pragma unroll
        for (int rg = 0; rg < 4; ++rg) { const int tok = task * 16 + 4 * q + rg; const f32x4* sp = (const f32x4*)(SSQ + (size_t)tok * 16); const f32x4 s0 = sp[0], s1 = sp[1], s2 = sp[2], s3 = sp[3];
            const float s = ((s0[0] + s0[1]) + (s0[2] + s0[3])) + ((s1[0] + s1[1]) + (s1[2] + s1[3])) + ((s2[0] + s2[1]) + (s2[2] + s2[3])) + ((s3[0] + s3[1]) + (s3[2] + s3[3]));
            DT[(size_t)tok * 16 + r16] = acc[rg] * rsqrtf(s * (1.0f / 1024.0f) + EPS); }
    }
    __syncthreads();
}

#else
__device__ __forceinline__ void dt_units(Frame& F, const bf16* __restrict__ XN, const bf16* __restrict__ Wdt, const float* __restrict__ SSQ, float* __restrict__ DT) {
    const int gw = F.vcu * NWAVES + F.wave, NGW = F.G * NWAVES, r16 = F.lane & 15, q = F.lane >> 4;
    for (int task = gw; task < M / 16; task += NGW) {
        const bf16* ap = XN + (size_t)(task * 16 + r16) * D_MODEL + 8 * q; const bf16* bp = Wdt + (size_t)r16 * D_MODEL + 8 * q;
        float zf = 0.f; asm volatile("" : "+v"(zf)); f32x4 acc = {zf, zf, zf, zf};
#pragma unroll 1
        for (int kb = 0; kb < D_MODEL; kb += 256) {
            bf16x8 av[8], bv[8];
#pragma unroll
            for (int j = 0; j < 8; ++j) { av[j] = *(const bf16x8*)(ap + kb + 32 * j); bv[j] = *(const bf16x8*)(bp + kb + 32 * j); }
            __builtin_amdgcn_sched_barrier(0);
#pragma unroll
            for (int j = 0; j < 8; ++j) acc = __builtin_amdgcn_mfma_f32_16x16x32_bf16(av[j], bv[j], acc, 0, 0, 0);
            __builtin_amdgcn_sched_barrier(0);
        }
        f32x4 sq[4][4];
#pragma unroll
        for (int rg = 0; rg < 4; ++rg) { const f32x4* sp = (const f32x4*)(SSQ + (size_t)(task * 16 + 4 * q + rg) * 16);
#pragma unroll
            for (int j = 0; j < 4; ++j) sq[rg][j] = sp[j]; }
        __builtin_amdgcn_sched_barrier(0);
#pragma unroll
        for (int rg = 0; rg < 4; ++rg) { const int tok = task * 16 + 4 * q + rg; const f32x4 s0 = sq[rg][0], s1 = sq[rg][1], s2 = sq[rg][2], s3 = sq[rg][3];
            const float s = ((s0[0] + s0[1]) + (s0[2] + s0[3])) + ((s1[0] + s1[1]) + (s1[2] + s1[3])) + ((s2[0] + s2[1]) + (s2[2] + s2[3])) + ((s3[0] + s3[1]) + (s3[2] + s3[3]));
            DT[(size_t)tok * 16 + r16] = acc[rg] * rsqrtf(s * (1.0f / 1024.0f) + EPS); }
    }
}

#endif
__device__ __forceinline__ void final_rows(Frame& F, float* __restrict__ out, const bf16* __restrict__ XN, const float* __restrict__ SSQ, const float* __restrict__ fw, const int rbase, const int gw, const int NGW, const int nrow) {
    f32x4 w[4];
#pragma unroll
    for (int j = 0; j < 4; ++j) w[j] = ((const f32x4*)fw)[F.lane + 64 * j];
    for (int r_ = gw; r_ < nrow; r_ += NGW) { const int row = rbase + r_;
        const float sv = F.lane < 16 ? SSQ[(size_t)row * 16 + F.lane] : 0.f; const float r = rsqrtf(wave_sum(sv) * (1.0f / 1024.0f) + EPS);
        const unsigned long long* xr = (const unsigned long long*)(XN + (size_t)row * D_MODEL); f32x4* orow = (f32x4*)(out + (size_t)row * D_MODEL);
#pragma unroll
        for (int j = 0; j < 4; ++j) { const unsigned long long v = xr[F.lane + 64 * j]; const unsigned lo = (unsigned)v, hi = (unsigned)(v >> 32);
            const f32x4 x = {__uint_as_float(lo << 16), __uint_as_float(lo & 0xffff0000u), __uint_as_float(hi << 16), __uint_as_float(hi & 0xffff0000u)};
            orow[F.lane + 64 * j] = x * r * w[j]; }
    }
}

constexpr int RST_OFF = TAB_OFF + 8192, QKW_OFF = RST_OFF + 12 * 1024;
template <class Sched>
__device__ __forceinline__ void fill_rstd_table(LAS unsigned char* lds, const float* __restrict__ SSQ, const Sched& S, int tid) {
    pg8::Unit u0; S.next(0, u0);
    f32x4 a[12], b[12]; bool ok[12];
#pragma unroll
    for (int i = 0; i < 12; ++i) { pg8::Unit u; ok[i] = S.next(i, u); const int pm = ok[i] ? u.pm : u0.pm; const float* p = SSQ + (size_t)(pm * 256 + (tid >> 1)) * 16 + (tid & 1) * 8; a[i] = *(const f32x4*)p; b[i] = *(const f32x4*)(p + 4); }
#pragma unroll
    for (int i = 0; i < 12; ++i) { float s = ((a[i][0] + a[i][1]) + (a[i][2] + a[i][3])) + ((b[i][0] + b[i][1]) + (b[i][2] + b[i][3])); s += __shfl_xor(s, 1);
        if (ok[i] && (tid & 1) == 0) ((LAS float*)(lds + RST_OFF))[i * 256 + (tid >> 1)] = rsqrtf(s * (1.0f / 1024.0f) + EPS); }
}
__global__ void __launch_bounds__(NWAVES * 64, 2) mega(Args args) {
    extern __shared__ __attribute__((aligned(16))) unsigned char lds[];
    Frame F;
    F.lds = (LAS unsigned char*)lds; F.MISC = (volatile LAS unsigned*)(F.lds + MISC_OFF);
    F.tid = threadIdx.x; F.lane = F.tid & 63; F.wave = __builtin_amdgcn_readfirstlane(F.tid >> 6);
    F.G = gridDim.x; { const int bx = blockIdx.x; F.vcu = (F.G % 8 == 0) ? (bx % 8) * (F.G / 8) + bx / 8 : bx; }
    for (int u = F.tid; u < (LDS_BYTES - LDSCTL_OFF) / 4; u += NWAVES * 64) ((LAS unsigned*)(F.lds + LDSCTL_OFF))[u] = 0u;
    __syncthreads();
    if (F.tid == 0) { F.MISC[12] = blockIdx.x; F.MISC[13] = (unsigned)F.vcu; F.MISC[14] = 0u; }
    __syncthreads();
    XcdBarrier bar = xcd_barrier_post((unsigned*)(args.ws + WS_CTL) + CW_BAR, F.MISC + 8);
    const int lo = args.ph_lo, hi = args.ph_hi;
#define IN(k) (lo <= (k) && (k) < hi)
#ifndef REP_BAR
#define REP_BAR 1
#endif
#define SEAM(k) do { if (IN(k) && IN((k) + 1)) for (int rb_ = 0; rb_ < REP_BAR; ++rb_) xcd_barrier(bar); } while (0)
#ifndef OPT_AFFINE
#define OPT_AFFINE 1
#endif
#ifndef REP_LBAR
#define REP_LBAR 1
#endif
#define SEAML(k) do { if (IN(k) && IN((k) + 1)) for (int rb_ = 0; rb_ < REP_LBAR; ++rb_) { if (__builtin_amdgcn_readfirstlane((int)F.MISC[14])) xcd_barrier_local(bar); else xcd_barrier(bar); } } while (0)
#define PHASE_PTRS() int z_ = 0; asm volatile("" : "+s"(z_)); unsigned char* ws = args.ws + z_; (void)ws; \
    Frame Fp = F; Fp.lane = mk_lane(); Fp.tid = F.wave * 64 + Fp.lane; Fp.vcu = __builtin_amdgcn_readfirstlane((int)F.MISC[13]); const int cidx = __builtin_amdgcn_readfirstlane((int)F.MISC[12]); (void)cidx; \
    float* SSQ = (float*)(ws + WS_SSQ); float* DT = (float*)(ws + WS_DT); const float* TAB = (const float*)(ws + WS_ROPE); \
    pg8::bf16_t* XN = (pg8::bf16_t*)(ws + WS_XN); pg8::bf16_t* MIX = (pg8::bf16_t*)(ws + WS_MIX); \
    pg8::bf16_t* Q = (pg8::bf16_t*)(ws + WS_Q); pg8::bf16_t* Kb = (pg8::bf16_t*)(ws + WS_K); pg8::bf16_t* Vb = (pg8::bf16_t*)(ws + WS_V); \
    pg8::bf16_t* Z = (pg8::bf16_t*)(ws + WS_Z); pg8::bf16_t* XR = (pg8::bf16_t*)(ws + WS_XBCR); pg8::bf16_t* HFF = (pg8::bf16_t*)(ws + WS_HFF); \
    (void)SSQ; (void)DT; (void)TAB; (void)XN; (void)MIX; (void)Q; (void)Kb; (void)Vb; (void)Z; (void)XR; (void)HFF
#define AIN(i) (args.in[(i) + z_])

#ifndef DIS_P0
    for (int rep_ = 0; rep_ < REP_P0; ++rep_) if (IN(0)) { Frame Fp = F; Fp.lane = mk_lane(); Fp.tid = F.wave * 64 + Fp.lane; p0_prologue(Fp, args); }
#endif
    SEAM(0);
    if (OPT_AFFINE && IN(0) && IN(1)) {
        if (F.tid == 0 && F.MISC[8 + 2] == 2u) { const unsigned rank = F.MISC[8 + 3]; F.MISC[12] = rank * 8u + bar.x; F.MISC[13] = bar.x * (unsigned)(F.G / 8) + rank; F.MISC[14] = 1u; }
        __syncthreads();
    }
    bool fusedfin = false;
#pragma unroll
    for (int l = 0; l < DEPTH; ++l) {
        const int pb = 1 + 7 * l;
#ifndef DIS_P1
        for (int rep_ = 0; rep_ < REP_IN; ++rep_) if (IN(pb)) {
            PHASE_PTRS();
            pg8::Gemm g{XN, (const pg8::bf16_t*)(ws + WS_WIN) + (size_t)l * NINM * D_MODEL, M, NINM, D_MODEL}; pg8::OrdOrder S; S.init(M, NINM, Fp.G, cidx);
            { LAS float* tl = (LAS float*)(Fp.lds + TAB_OFF); for (int i = Fp.tid; i < 2048; i += NWAVES * 64) tl[i] = TAB[i];
              if (Fp.tid < 128) ((LAS float*)(Fp.lds + QKW_OFF))[Fp.tid] = Fp.tid < 64 ? AIN(3)[l * 64 + Fp.tid] : AIN(4)[l * 64 + Fp.tid - 64]; }
            fill_rstd_table(Fp.lds, SSQ, S, Fp.tid);
            __syncthreads();
            pg8::EpiInProj E{Q, Kb, Vb, Z, XR, (const LAS float*)(Fp.lds + RST_OFF), (const LAS float*)(Fp.lds + QKW_OFF), (const LAS float*)(Fp.lds + TAB_OFF)};
            pg8::gemm_phase<pg8::EpiInProj, pg8::OrdOrder, GEMM_ALIGN, GEMM_SP2>(Fp.lds + RING_OFF, g, S, E, F.wave);
#ifndef REP_DT
#define REP_DT 1
#endif
            const int nun = (M / 256) * (NINM / 256), rem = nun % Fp.G, first = rem, nb = Fp.G - first;
#ifndef OPT_DTLIGHT
#define OPT_DTLIGHT 1
#endif
#if OPT_DT == 2
            { const int gx = cidx & 7, gr = cidx >> 3, gr0 = (OPT_DTLIGHT && Fp.G % 8 == 0 && first % 8 == 0) ? first / 8 : 0, ngr = Fp.G / 8 - gr0;
              if (Fp.G % 8 == 0) { if (gr >= gr0) dt_units(Fp, XN, (const bf16*)(ws + WS_WDT) + (size_t)l * 16 * D_MODEL, SSQ, DT, gx * (M / 16 / 8), (gr - gr0) * NWAVES + Fp.wave, ngr * NWAVES, M / 16 / 8); }
              else dt_units(Fp, XN, (const bf16*)(ws + WS_WDT) + (size_t)l * 16 * D_MODEL, SSQ, DT, 0, cidx * NWAVES + Fp.wave, Fp.G * NWAVES, M / 16); }
#else
            for (int rd_ = 0; rd_ < REP_DT; ++rd_) { dt_units(Fp, XN, (const bf16*)(ws + WS_WDT) + (size_t)l * 16 * D_MODEL, SSQ, DT); if (REP_DT > 1) asm volatile("s_waitcnt vmcnt(0)" ::: "memory"); }
#endif
            if (OPT_A && l + 1 < DEPTH) {
                if (cidx >= first) convert_layer_weights(Fp, args, l + 1, (cidx - first) * NWAVES + Fp.wave, nb * NWAVES);
            }
        }
#endif
        SEAML(pb);
        if (IN(pb + 1) && IN(pb + 2) && IN(pb + 3)) {
            const bool aff_ = __builtin_amdgcn_readfirstlane((int)F.MISC[14]) != 0;
#ifndef OPT_ROT
#define OPT_ROT 1
#endif
            const int p_ = OPT_ROT ? ((__builtin_amdgcn_readfirstlane((int)F.MISC[12]) >> 3) & 1) : 0;
            const int nat_ = (1024 + F.G - 1) / F.G, nk_ = (nat_ > p_ + 3 ? nat_ : p_ + 3);
#pragma unroll 1
            for (int k = 0; k < nk_; ++k) {
                if (k == p_) { PHASE_PTRS();
                    const int upc = (512 + Fp.G - 1) / Fp.G;
                    for (int i = 0; i < upc; ++i) { const int u = Fp.vcu * upc + i; if (u >= 512) break;
                        ssd::ssa_unit(Fp.lds, XR + (size_t)(u >> 6) * XADJ, DT, AIN(5) + (size_t)l * 5 * NCONV, AIN(6) + l * NCONV, AIN(7) + l * 16, AIN(8) + l * 16, AIN(9) + l * 8, (bf16*)(ws + WS_ST) + (size_t)(u >> 6) * SADJ, (float*)(ws + WS_CD), (bf16*)(ws + WS_YD) + (size_t)(u >> 6) * YADJ, (bf16*)(ws + WS_CIMG) + (size_t)(u >> 6) * CADJ, (float*)(ws + WS_EX), u >> 6, (u >> 1) & 31, u & 1, F.wave); }
                    if (aff_) xcd_local_arrive(bar); else __syncthreads();
                } else if (k == p_ + 1) { if (aff_) xcd_local_wait(bar); else xcd_barrier(bar);
                    { PHASE_PTRS(); ssd::s2_scan((bf16*)(ws + WS_ST), (const float*)(ws + WS_CD), Fp.vcu * (NWAVES * 64) + Fp.tid, Fp.G * NWAVES * 64, SADJ); }
                    if (aff_) xcd_local_arrive(bar); else __syncthreads();
                } else if (k == p_ + 2) { if (aff_) xcd_local_wait(bar); else xcd_barrier(bar);
                    PHASE_PTRS();
                    const int upc = (512 + Fp.G - 1) / Fp.G;
                    for (int i = 0; i < upc; ++i) { const int u = Fp.vcu * upc + i; if (u >= 512) break;
                        ssd::ssb_unit(Fp.lds, Z, AIN(10) + l * NSSD, (const bf16*)(ws + WS_ST) + (size_t)(u >> 6) * SADJ, (const bf16*)(ws + WS_YD) + (size_t)(u >> 6) * YADJ, (const bf16*)(ws + WS_CIMG) + (size_t)(u >> 6) * CADJ, (const float*)(ws + WS_EX), MIX, u >> 6, (u >> 1) & 31, u & 1, F.wave); }
                    __syncthreads();
                }
                if (k < nat_) { PHASE_PTRS();
                    const int gidx = Fp.vcu * nat_ + k;
                    if (gidx < 1024) { const int bg = gidx >> 6, r = gidx & 63, b = bg >> 1, h = (bg & 1) * 4 + (r >> 4), qb = r & 15;
                        attn_body::attn_unit<8>(b, h, qb, (const attn_body::bf16*)Q, (const attn_body::bf16*)Kb, (const attn_body::bf16*)Vb, (attn_body::bf16*)MIX, (char*)lds + RING_OFF, F.wave); }
                    __syncthreads(); }
            }
        }
        SEAML(pb + 3);
#ifndef DIS_P4
        for (int rep_ = 0; rep_ < (l == 0 ? REP_OUT0 : 1); ++rep_) if (IN(pb + 4)) {
            PHASE_PTRS();
            pg8::Gemm g{MIX, (const pg8::bf16_t*)(ws + WS_WOUT) + (size_t)l * D_MODEL * D_MODEL, M, D_MODEL, D_MODEL}; pg8::StaticOrder S; S.init(M, D_MODEL, Fp.G, cidx);
            pg8::EpiResid E{l == 0 ? AIN(0) : (const float*)nullptr, XN, SSQ};
            pg8::gemm_phase<pg8::EpiResid, pg8::StaticOrder, GEMM_ALIGN, GEMM_SP2>(Fp.lds + RING_OFF, g, S, E, F.wave);
        }
#endif
        SEAML(pb + 4);
#ifndef DIS_P5
        for (int rep_ = 0; rep_ < REP_GU; ++rep_) if (IN(pb + 5)) {
            PHASE_PTRS();
#ifdef CLKPROBE
            unsigned long long ck0 = 0, rt0 = 0; if (l == CLKPROBE_L && blockIdx.x == 0 && F.wave == 0) { ck0 = __builtin_amdgcn_s_memtime(); rt0 = __builtin_amdgcn_s_memrealtime(); }
#endif
#ifndef GU_WGM
#define GU_WGM 8
#endif
#ifndef GU_WGM_P
#define GU_WGM_P GU_WGM
#endif
#ifndef GU_N
#define GU_N NGU
#endif
#ifndef GU_K
#define GU_K D_MODEL
#endif
            pg8::Gemm g{XN, (const pg8::bf16_t*)(ws + WS_WGU) + (size_t)l * NGU * D_MODEL, M, (REP_GU > 1 && rep_ == 0) ? GU_N : NGU, (REP_GU > 1 && rep_ == 0) ? GU_K : D_MODEL}; pg8::OrdOrder S; S.init(M, (REP_GU > 1 && rep_ == 0) ? GU_N : NGU, Fp.G, cidx, (REP_GU > 1 && rep_ == 0) ? GU_WGM_P : GU_WGM);
            fill_rstd_table(Fp.lds, SSQ, S, Fp.tid);
            __syncthreads();
#ifndef GU_VAR
#define GU_VAR 0
#endif
            pg8::EpiSwiglu E{HFF, (const LAS float*)(Fp.lds + RST_OFF), (REP_GU > 1 && rep_ == 0) ? GU_VAR : 0};
            pg8::gemm_phase<pg8::EpiSwiglu, pg8::OrdOrder, GEMM_ALIGN, GEMM_SP2>(Fp.lds + RING_OFF, g, S, E, F.wave);
#ifdef CLKPROBE
            if (l == CLKPROBE_L && blockIdx.x == 0 && F.wave == 0) { const unsigned long long ck1 = __builtin_amdgcn_s_memtime(), rt1 = __builtin_amdgcn_s_memrealtime();
                if (Fp.lane == 0) F.MISC[16] = (unsigned)(((ck1 - ck0) * 10000ull) / (rt1 - rt0 + 1ull)); }
#endif
        }
#endif
        SEAML(pb + 5);
#ifndef DIS_P6
        if (IN(pb + 6)) {
            PHASE_PTRS();
            pg8::Gemm g{HFF, (const pg8::bf16_t*)(ws + WS_WDN) + (size_t)l * D_MODEL * DFF, M, D_MODEL, DFF}; pg8::StaticOrder S; S.init(M, D_MODEL, Fp.G, cidx);
#ifndef OPT_FUSEFINAL
#define OPT_FUSEFINAL 1
#endif
            fusedfin = OPT_FUSEFINAL && l == DEPTH - 1 && Fp.G == 256 && IN(15) && __builtin_amdgcn_readfirstlane((int)F.MISC[14]) != 0;
            if (fusedfin) { pg8::EpiResidFinal E{XN, SSQ, args.out, AIN(16), (unsigned*)(ws + WS_CTL) + CW_PANEL, (LAS float*)(Fp.lds + RST_OFF), (unsigned*)(ws + WS_CTL) + CW_BAR + XB_TMO};
                pg8::gemm_phase<pg8::EpiResidFinal, pg8::StaticOrder, GEMM_ALIGN, GEMM_SP2>(Fp.lds + RING_OFF, g, S, E, F.wave); }
            else { pg8::EpiResid E{nullptr, XN, SSQ};
                pg8::gemm_phase<pg8::EpiResid, pg8::StaticOrder, GEMM_ALIGN, GEMM_SP2>(Fp.lds + RING_OFF, g, S, E, F.wave); }
        }
#endif
        if (fusedfin) {} else if (OPT_A && l + 1 < DEPTH) SEAM(pb + 6); else SEAML(pb + 6);
    }
    if (IN(15) && !fusedfin) { PHASE_PTRS();
        if (Fp.G % 8 == 0) final_rows(Fp, args.out, XN, SSQ, AIN(16), (cidx & 7) * (M / 8), (cidx >> 3) * NWAVES + Fp.wave, (Fp.G / 8) * NWAVES, M / 8);
        else final_rows(Fp, args.out, XN, SSQ, AIN(16), 0, cidx * NWAVES + Fp.wave, Fp.G * NWAVES, M); }
#ifdef CLKPROBE
    if (hi == NPHASE && blockIdx.x == 0 && F.wave == 0) { const unsigned ticks = F.MISC[16]; const unsigned long long s0 = __builtin_amdgcn_s_memrealtime(); while (__builtin_amdgcn_s_memrealtime() - s0 < (unsigned long long)ticks) __builtin_amdgcn_s_sleep(8); }
#endif
#undef PHASE_PTRS
#undef AIN
#undef IN
#undef SEAM
#undef SEAML
}

extern "C" void kernel_launch(void* const* d_in, const int* in_sizes, int n_in, void* d_out, int out_size, void* d_ws, size_t ws_size, hipStream_t stream) {
    static int grid = 0;
    if (grid == 0) {
        int dev = 0, cus = 0;
        if (hipGetDevice(&dev) != hipSuccess || hipDeviceGetAttribute(&cus, hipDeviceAttributeMultiprocessorCount, dev) != hipSuccess) { fprintf(stderr, "device query failed\n"); grid = -1; return; }
        if (hipFuncSetAttribute((const void*)mega, hipFuncAttributeMaxDynamicSharedMemorySize, LDS_BYTES) != hipSuccess) { fprintf(stderr, "hipFuncSetAttribute failed\n"); grid = -1; return; }
        (void)hipGetLastError();
        grid = cus;
    }
    if (grid < 0) return;
    unsigned char* ws = (unsigned char*)d_ws; float* out = (float*)d_out;
    (void)hipMemsetAsync(ws + WS_CTL, 0, CTL_ZERO_BYTES, stream);
    Args a{};
    for (int i = 0; i < 17; ++i) a.in[i] = (const float*)d_in[i];
    a.out = out; a.ws = ws;
    auto run = [&](int lo, int hi) { a.ph_lo = lo; a.ph_hi = hi; hipLaunchKernelGGL(mega, dim3(grid), dim3(NWAVES * 64), LDS_BYTES, stream, a); };
#ifdef MULTI_LAUNCH
    run(0, 1);
    for (int l = 0; l < DEPTH; ++l) { const int pb = 1 + 7 * l; for (int k = 0; k < 7; ++k) run(pb + k, pb + k + 1); }
    run(15, 16);
#else
    run(0, NPHASE);
#endif
}
```
